# Optimizing an MI355X kernel written in HIP

```python
import math
import jax
import jax.numpy as jnp
from jax import lax
import numpy as np

D_MODEL = 1024
BATCH = 8
SEQ = 8192
DEPTH = 1

CHUNK = 64
Q_BLOCK = 128

A_HEADS = 8
A_HEAD_DIM = 64
A_WIDTH = A_HEADS * A_HEAD_DIM
IDX_HEADS = 8
IDX_DIM = 64
IDX_TOPK_MAX = 256

B_HEADS = 4
B_QK_DIM = 64
B_V_DIM = 128
B_QK_WIDTH = B_HEADS * B_QK_DIM
B_WIDTH = B_HEADS * B_V_DIM

MIX_WIDTH = A_WIDTH + B_WIDTH
IN_WIDTH = 3 * A_WIDTH + IDX_HEADS * IDX_DIM + IDX_DIM + IDX_HEADS + 2 * B_QK_WIDTH + 2 * B_WIDTH

REL_BUCKETS = 32
REL_MAX_DIST = 128

N_EXPERTS = 32
TOP_K = 4
D_FF = 1024
SWIGLU_LIMIT = 7.0
SWIGLU_ALPHA = 1.702

ROPE_BASE = 10000.0
RMS_EPS = 1e-5
LN_EPS = 1e-6

kernel_name = "hybrid_dsa_retention_moe_block"


def rms_norm(x, gain):
    xf = x.astype(jnp.float32)
    y = xf * lax.rsqrt(jnp.mean(xf * xf, axis=-1, keepdims=True) + RMS_EPS)
    return (y * gain.astype(jnp.float32)).astype(x.dtype)


def layer_norm(x, gain, bias):
    xf = x.astype(jnp.float32)
    mu = jnp.mean(xf, axis=-1, keepdims=True)
    var = jnp.mean(jnp.square(xf - mu), axis=-1, keepdims=True)
    y = (xf - mu) * lax.rsqrt(var + LN_EPS)
    return (y * gain.astype(jnp.float32) + bias.astype(jnp.float32)).astype(x.dtype)


def t5_bucket(rel):
    nb = REL_BUCKETS // 2
    max_exact = nb // 2
    ret = jnp.where(rel > 0, nb, 0)
    n = jnp.abs(rel)
    nf = jnp.maximum(n, 1).astype(jnp.float32)
    large = max_exact + (jnp.log(nf / max_exact) / math.log(REL_MAX_DIST / max_exact)
                         * (nb - max_exact)).astype(jnp.int32)
    large = jnp.minimum(large, nb - 1)
    return ret + jnp.where(n < max_exact, n, large)


def rotary(x, pos):
    half = x.shape[-1] // 2
    inv = 1.0 / (ROPE_BASE ** jnp.linspace(0.0, 1.0, half, dtype=jnp.float32))
    ang = pos.astype(jnp.float32)[:, None] * inv[None, :]
    cos = jnp.cos(ang)[None, :, None, :]
    sin = jnp.sin(ang)[None, :, None, :]
    xf = x.astype(jnp.float32)
    x1, x2 = xf[..., :half], xf[..., half:]
    return jnp.concatenate([x1 * cos - x2 * sin, x2 * cos + x1 * sin], axis=-1).astype(x.dtype)


def dsa_attention(q, k, v, q_idx, k_idx, w_idx, rel_bias, topk):
    bsz, s, h, dh = q.shape
    nb = s // Q_BLOCK
    key_pos = jnp.arange(s, dtype=jnp.int32)
    scale = dh ** -0.5

    def blockify(a):
        return a.reshape(bsz, nb, Q_BLOCK, *a.shape[2:]).swapaxes(0, 1)

    def one_block(args):
        blk, qb, qib, wb = args
        q_pos = blk * Q_BLOCK + jnp.arange(Q_BLOCK, dtype=jnp.int32)
        limit = (q_pos // CHUNK + 1) * CHUNK
        admissible = key_pos[None, :] < limit[:, None]
        dots = jnp.einsum('bqhd,bsd->bqhs', qib, k_idx, preferred_element_type=jnp.float32)
        score = jnp.einsum('bqhs,bqh->bqs', jax.nn.relu(dots), wb.astype(jnp.float32))
        score = jnp.where(admissible[None], score, -jnp.inf)
        _, idx = lax.top_k(score, topk)
        valid = idx < limit[None, :, None]
        k_sel = jax.vmap(lambda kb, ib: kb[ib])(k, idx)
        v_sel = jax.vmap(lambda vb, ib: vb[ib])(v, idx)
        logits = jnp.einsum('bqhd,bqkhd->bhqk', qb, k_sel,
                            preferred_element_type=jnp.float32) * scale
        bias = rel_bias.astype(jnp.float32)[t5_bucket(idx - q_pos[None, :, None])]
        logits = logits + jnp.transpose(bias, (0, 3, 1, 2))
        logits = jnp.where(valid[:, None], logits, -jnp.inf)
        p = jax.nn.softmax(logits, axis=-1).astype(v.dtype)
        return jnp.einsum('bhqk,bqkhd->bqhd', p, v_sel)

    out = lax.map(one_block, (jnp.arange(nb, dtype=jnp.int32), blockify(q),
                              blockify(q_idx), blockify(w_idx)))
    return out.swapaxes(0, 1).reshape(bsz, s, h, dh)


def retention(q, k, v):
    bsz, s, h, dk = q.shape
    dv = v.shape[-1]
    nc = s // CHUNK
    f32 = jnp.float32
    log_g = jnp.log(1.0 - 2.0 ** (-5.0 - jnp.arange(h, dtype=f32)))
    n = jnp.arange(CHUNK, dtype=f32)
    diff = n[:, None] - n[None, :]
    decay = jnp.where(diff >= 0, jnp.exp(log_g[:, None, None] * jnp.maximum(diff, 0.0)), 0.0)
    zeta = jnp.exp(log_g[:, None] * (CHUNK - 1.0 - n)[None, :])
    xi = jnp.exp(log_g[:, None] * (n + 1.0)[None, :])
    chunk_decay = jnp.exp(log_g * CHUNK)
    qc = q.reshape(bsz, nc, CHUNK, h, dk).astype(f32)
    kc = k.reshape(bsz, nc, CHUNK, h, dk).astype(f32) * (dk ** -0.5)
    vc = v.reshape(bsz, nc, CHUNK, h, dv).astype(f32)
    scores = jnp.einsum('bcnhd,bcmhd->bchnm', qc, kc) * decay[None, None]
    intra = jnp.einsum('bchnm,bcmhe->bcnhe', scores, vc)
    kv = jnp.einsum('bcmhd,hm,bcmhe->cbhde', kc, zeta, vc)

    def step(state, kv_c):
        return chunk_decay[None, :, None, None] * state + kv_c, state

    _, prev = lax.scan(step, jnp.zeros((bsz, h, dk, dv), f32), kv)
    cross = jnp.einsum('bcnhd,cbhde,hn->bcnhe', qc, prev, xi)
    return (intra + cross).reshape(bsz, s, h, dv)


def moe_ffn(h, w_router, b_router, w1, b1, w2, b2):
    logits = (jnp.einsum('bsd,de->bse', h, w_router) + b_router).astype(jnp.float32)
    top_val, top_idx = lax.top_k(logits, TOP_K)
    gates = jax.nn.softmax(top_val, axis=-1)
    combine = jnp.sum(jax.nn.one_hot(top_idx, N_EXPERTS, dtype=jnp.float32)
                      * gates[..., None], axis=-2).astype(h.dtype)
    out = jnp.zeros(h.shape, h.dtype)
    for e in range(N_EXPERTS):
        z = jnp.einsum('bsd,df->bsf', h, w1[e]) + b1[e]
        glu = jnp.minimum(z[..., 0::2], SWIGLU_LIMIT)
        lin = jnp.clip(z[..., 1::2], -SWIGLU_LIMIT, SWIGLU_LIMIT)
        act = glu * jax.nn.sigmoid(SWIGLU_ALPHA * glu) * (lin + 1.0)
        out = out + combine[..., e:e + 1] * (jnp.einsum('bsf,fd->bsd', act, w2[e]) + b2[e])
    return out


def setup_inputs(seed: int = 0) -> dict:
    key = jax.random.key(seed)
    ks = jax.random.split(key, 16)
    f32 = jnp.float32

    def nrm(k, shape, scale):
        return jax.random.normal(k, shape, f32) * scale

    return {
        "x": nrm(ks[0], (BATCH, SEQ, D_MODEL), 1.0),
        "norm1_gain": 1.0 + nrm(ks[1], (DEPTH, D_MODEL), 0.02),
        "w_in": nrm(ks[2], (DEPTH, D_MODEL, IN_WIDTH), D_MODEL ** -0.5),
        "rel_bias": nrm(ks[3], (REL_BUCKETS, A_HEADS), 0.5),
        "idx_k_ln_gain": 1.0 + nrm(ks[4], (DEPTH, IDX_DIM), 0.02),
        "idx_k_ln_bias": nrm(ks[5], (DEPTH, IDX_DIM), 0.02),
        "ret_gn_gain": 1.0 + nrm(ks[6], (DEPTH, B_WIDTH), 0.02),
        "w_out": nrm(ks[7], (DEPTH, MIX_WIDTH, D_MODEL), MIX_WIDTH ** -0.5),
        "norm2_gain": 1.0 + nrm(ks[8], (DEPTH, D_MODEL), 0.02),
        "w_router": nrm(ks[9], (DEPTH, D_MODEL, N_EXPERTS), D_MODEL ** -0.5),
        "b_router": nrm(ks[10], (DEPTH, N_EXPERTS), 0.01),
        "w_mlp1": nrm(ks[11], (DEPTH, N_EXPERTS, D_MODEL, 2 * D_FF), D_MODEL ** -0.5),
        "b_mlp1": nrm(ks[12], (DEPTH, N_EXPERTS, 2 * D_FF), 0.01),
        "w_mlp2": nrm(ks[13], (DEPTH, N_EXPERTS, D_FF, D_MODEL), D_FF ** -0.5),
        "b_mlp2": nrm(ks[14], (DEPTH, N_EXPERTS, D_MODEL), 0.01),
        "final_gain": 1.0 + nrm(ks[15], (D_MODEL,), 0.02),
    }


def reference(x, norm1_gain, w_in, rel_bias, idx_k_ln_gain, idx_k_ln_bias, ret_gn_gain,
              w_out, norm2_gain, w_router, b_router, w_mlp1, b_mlp1, w_mlp2, b_mlp2,
              final_gain):
    bsz, s, _ = x.shape
    topk = min(IDX_TOPK_MAX, s // 4)
    pos = jnp.arange(s, dtype=jnp.int32)
    sizes = (A_WIDTH, A_WIDTH, A_WIDTH, IDX_HEADS * IDX_DIM, IDX_DIM, IDX_HEADS,
             B_QK_WIDTH, B_QK_WIDTH, B_WIDTH, B_WIDTH)
    cuts = np.cumsum(sizes)[:-1].tolist()
    idx_w_scale = (IDX_HEADS ** -0.5) * (IDX_DIM ** -0.5)

    for layer in range(DEPTH):
        h = rms_norm(x, norm1_gain[layer])
        proj = jnp.einsum('bsd,dn->bsn', h, w_in[layer])
        q_a, k_a, v_a, q_i, k_i, w_i, q_b, k_b, v_b, g_b = jnp.split(proj, cuts, axis=-1)

        q_a = q_a.reshape(bsz, s, A_HEADS, A_HEAD_DIM)
        k_a = k_a.reshape(bsz, s, A_HEADS, A_HEAD_DIM)
        v_a = v_a.reshape(bsz, s, A_HEADS, A_HEAD_DIM)
        q_i = q_i.reshape(bsz, s, IDX_HEADS, IDX_DIM)
        k_i = layer_norm(k_i, idx_k_ln_gain[layer], idx_k_ln_bias[layer])
        w_i = w_i * idx_w_scale
        out_a = dsa_attention(q_a, k_a, v_a, q_i, k_i, w_i, rel_bias, topk)
        out_a = out_a.reshape(bsz, s, A_WIDTH)

        q_b = rotary(q_b.reshape(bsz, s, B_HEADS, B_QK_DIM), pos)
        k_b = rotary(k_b.reshape(bsz, s, B_HEADS, B_QK_DIM), pos)
        v_b = v_b.reshape(bsz, s, B_HEADS, B_V_DIM)
        y_b = retention(q_b, k_b, v_b)
        mu = jnp.mean(y_b, axis=-1, keepdims=True)
        var = jnp.mean(jnp.square(y_b - mu), axis=-1, keepdims=True)
        y_b = ((y_b - mu) * lax.rsqrt(var + LN_EPS)).reshape(bsz, s, B_WIDTH)
        y_b = (y_b * ret_gn_gain[layer].astype(jnp.float32)).astype(x.dtype)
        out_b = jax.nn.silu(g_b) * y_b

        mixed = jnp.concatenate([out_a, out_b], axis=-1)
        x = x + jnp.einsum('bsm,md->bsd', mixed, w_out[layer])

        h2 = rms_norm(x, norm2_gain[layer])
        x = x + moe_ffn(h2, w_router[layer], b_router[layer], w_mlp1[layer],
                        b_mlp1[layer], w_mlp2[layer], b_mlp2[layer])

    return rms_norm(x, final_gain)
```

```cpp
#include <hip/hip_runtime.h>
#include <hip/hip_bf16.h>
#include <cmath>
#include <stdint.h>
#include <stdio.h>

#ifndef MK_ONE_LAUNCH
#define MK_ONE_LAUNCH 1
#endif

#define GAS __attribute__((address_space(1)))
#define LAS __attribute__((address_space(3)))
typedef unsigned short bf16_t;
typedef short bf16x8 __attribute__((ext_vector_type(8)));
typedef float f32x4 __attribute__((ext_vector_type(4)));
typedef float f32x2 __attribute__((ext_vector_type(2)));
typedef float f32x16 __attribute__((ext_vector_type(16)));
typedef unsigned u32x4 __attribute__((ext_vector_type(4)));
typedef unsigned u32x2 __attribute__((ext_vector_type(2)));
typedef __bf16 bf16x2_t __attribute__((ext_vector_type(2)));

constexpr int NB = 8, SEQ = 8192, DM = 1024, MTOK = NB * SEQ;
constexpr int NP = 3840;
constexpr int C_QA = 0, C_VB = 512, C_KA = 1024, C_VA = 1536, C_QI = 2048, C_QB = 2560, C_KB = 2816, C_GB = 3072, C_KI = 3584, C_WI = 3648;
constexpr int NEXP = 32, DFF = 1024;
constexpr float LOG2E = 1.4426950408889634f;
constexpr float QA_SCALE = 0.125f * LOG2E;
constexpr float IDX_W_SCALE = 0.04419417382415922f;
constexpr int MAXROWS = MTOK * 4 + NEXP * 256;

constexpr size_t MiB = 1u << 20;
constexpr size_t WS_CTL = 0, CTL_ZERO_BYTES = 1 * MiB;
constexpr size_t WS_WIN = 1 * MiB;
constexpr size_t WS_WOUT = 9 * MiB;
constexpr size_t WS_INFO = 11 * MiB;
constexpr size_t WS_GATE = 12 * MiB;
constexpr size_t WS_TOKROW = 13 * MiB;
constexpr size_t WS_GROW = 14 * MiB + 256 * 1024;
constexpr size_t WS_WGCNT = 15 * MiB + 512 * 1024;
constexpr size_t WS_BASE = WS_WGCNT + 64 * 1024;
constexpr size_t WS_MTE = WS_BASE + 1024;
constexpr size_t WS_WRH = 15 * MiB + 640 * 1024;
constexpr size_t WS_WRL = WS_WRH + 64 * 1024;
constexpr size_t WS_RSTD = 15 * MiB + 768 * 1024;
constexpr size_t WS_RROW = 1000 * MiB;
constexpr size_t WS_W1T = 16 * MiB;
constexpr size_t WS_W2T = 80 * MiB;
constexpr size_t WS_KV = 16 * MiB;
constexpr size_t WS_MASK = 144 * MiB;
constexpr size_t WS_PROJ = 208 * MiB;
constexpr size_t WS_ACT = 208 * MiB;
constexpr size_t WS_Y = 472 * MiB;
constexpr size_t WS_H = 688 * MiB;
constexpr size_t WS_VTB = 688 * MiB;
constexpr size_t WS_QR = 752 * MiB;
constexpr size_t WS_KR = 784 * MiB;
constexpr size_t WS_VTA = 816 * MiB;
constexpr size_t WS_KTZ = 880 * MiB;
constexpr size_t WS_KILN = 912 * MiB;
constexpr size_t WS_WBUF = 920 * MiB;
constexpr size_t WS_H2 = 112 * MiB;
constexpr size_t WS_END = 1024 * MiB;
static_assert(WS_W1T + (size_t)NEXP * 2048 * 1024 <= WS_W2T && WS_W2T + (size_t)NEXP * 1024 * 1024 <= WS_H2 && WS_H2 + (size_t)MTOK * 1024 <= WS_ACT && WS_ACT + (size_t)(MAXROWS) * 1024 <= WS_Y && WS_Y + (size_t)MTOK * 4 * 1024 * 2 <= WS_END, "MoE buffers fit");

constexpr int CW_BAR = 4096;
constexpr int CW_Q_SCAN = 8192, CW_Q_ROUT = 8256;

constexpr int LDS_SCRATCH = 151552;
constexpr int LDSCTL_OFF = LDS_SCRATCH;
constexpr int LDS_BYTES = 155648;

__device__ __forceinline__ float bf2f(bf16_t b) { return __uint_as_float(((unsigned)b) << 16); }
__device__ __forceinline__ unsigned pk2(float lo, float hi) { f32x2 v = {lo, hi}; bf16x2_t b = __builtin_convertvector(v, bf16x2_t); return __builtin_bit_cast(unsigned, b); }
__device__ __forceinline__ bf16_t f2bf(float f) { return (bf16_t)(pk2(f, 0.f) & 0xffffu); }
__device__ __forceinline__ float wave_sum(float v) {
#pragma unroll
    for (int o = 1; o < 64; o <<= 1) v += __shfl_xor(v, o);
    return v;
}
__device__ __forceinline__ int crow(int r, int hi) { return (r & 3) + 8 * (r >> 2) + 4 * hi; }
__device__ __forceinline__ bf16x8 pack8(float a0, float a1, float a2, float a3, float a4, float a5, float a6, float a7) {
    u32x4 w; w.x = pk2(a0, a1); w.y = pk2(a2, a3); w.z = pk2(a4, a5); w.w = pk2(a6, a7); return __builtin_bit_cast(bf16x8, w);
}
__device__ __forceinline__ unsigned pk4_fp8(float a, float b, float c, float d) {
    a = fminf(fmaxf(a, -448.f), 448.f); b = fminf(fmaxf(b, -448.f), 448.f); c = fminf(fmaxf(c, -448.f), 448.f); d = fminf(fmaxf(d, -448.f), 448.f);
    int w = __builtin_amdgcn_cvt_pk_fp8_f32(a, b, 0, false); w = __builtin_amdgcn_cvt_pk_fp8_f32(c, d, w, true); return (unsigned)w; }
__device__ __forceinline__ unsigned pk4_fp8_nc(float a, float b, float c, float d) {
    int w = __builtin_amdgcn_cvt_pk_fp8_f32(a, b, 0, false); w = __builtin_amdgcn_cvt_pk_fp8_f32(c, d, w, true); return (unsigned)w; }
#define LDS_WAIT() asm volatile("s_waitcnt lgkmcnt(0)" ::: "memory")
#define VM_WAIT() asm volatile("s_waitcnt vmcnt(0)" ::: "memory")

namespace pg8 {
constexpr int BM = 256, BK = 64, HALF = 128, HTB = HALF * BK * 2, STAGE_BYTES = 8 * HTB, NXCD = 8, WGM = 8;
constexpr int ROWT_OFF = STAGE_BYTES, MTE_OFF = STAGE_BYTES + 2048;
constexpr int EPIT_OFF = MTE_OFF + 4352, EPIT_SLOT = 3072;
__host__ __device__ __forceinline__ int lds_byte(int r, int c) { const int st = (r >> 4) * 2 + (c >> 5), rr = r & 15, cc = c & 31, ob = rr * 64 + cc * 2; return st * 1024 + (ob ^ (((ob >> 9) & 1) << 5)); }
__host__ __device__ __forceinline__ void stage_rc(int b, int& R, int& C) { const int st = b / 1024, sb = b % 1024, swz = sb ^ (((sb >> 9) & 1) << 5); R = (st >> 1) * 16 + swz / 64; C = (st & 1) * 32 + (swz % 64) / 2; }
__host__ __device__ __forceinline__ int perm32(int rho) { const int n = rho >> 4, i = rho & 15; return 8 * (i >> 2) + 4 * n + (i & 3); }

struct Unit { int pm, pn, e; const char* B; };

typedef int v8i32 __attribute__((ext_vector_type(8)));
template <class Epi, class Sched, int MODE = 0>
__device__ __forceinline__ void gemm_phase(LAS unsigned char* lds, const char* Ab, unsigned lda2, int K, Sched& S, const Epi& E) {
    const int tid = threadIdx.x, wid = __builtin_amdgcn_readfirstlane(tid >> 6), lane = tid & 63, wr = wid >> 2, wc = wid & 3, fr = lane & 15, fq = lane >> 4;
    const int rowB = MODE ? K : 2 * K;
    const int nt = rowB / 128;
    int Rp[2]; unsigned Cp2[2], voffB[2];
#pragma unroll
    for (int i = 0; i < 2; ++i) { int R, C; stage_rc(tid * 16 + i * 8192, R, C); const int Rb = Epi::PERM ? ((R & ~31) + perm32(R & 31)) : R;
        Rp[i] = R; Cp2[i] = (unsigned)C * 2u; voffB[i] = (unsigned)(Rb * rowB + C * 2); }
    const size_t hstepB = (size_t)HALF * rowB;
    const unsigned ldsw = (unsigned)wid * 1024u;
    const int aoff = lds_byte(wr * 64 + fr, fq * 8), boff = lds_byte(wc * 32 + fr, fq * 8);
#define PG8_SA(b, h) (((b) * 2 + (h)) * HTB)
#define PG8_SB(b, h) ((4 + (b) * 2 + (h)) * HTB)
#define PG8_STAGE_B(bufoff, gbase) do { _Pragma("unroll") for (int _i = 0; _i < 2; ++_i) \
        __builtin_amdgcn_global_load_lds((const unsigned*)((const char*)(gbase) + voffB[_i]), (LAS unsigned*)(lds + (bufoff) + ldsw + _i * 8192), 16, 0, 0); } while (0)
#define PG8_STAGE_A(bufoff, o0, o1, kb) do { \
        __builtin_amdgcn_global_load_lds((const unsigned*)(Ab + (size_t)(o0) + (size_t)(kb)), (LAS unsigned*)(lds + (bufoff) + ldsw), 16, 0, 0); \
        __builtin_amdgcn_global_load_lds((const unsigned*)(Ab + (size_t)(o1) + (size_t)(kb)), (LAS unsigned*)(lds + (bufoff) + ldsw + 8192), 16, 0, 0); } while (0)
#define PG8_LD8(p) ({ const u32x4 lo_ = *(const LAS u32x4*)(p); const u32x4 hi_ = *(const LAS u32x4*)((p) + 1024); (v8i32){(int)lo_.x, (int)lo_.y, (int)lo_.z, (int)lo_.w, (int)hi_.x, (int)hi_.y, (int)hi_.z, (int)hi_.w}; })
#define PG8_LDA(dst, b, h) do { if constexpr (MODE == 0) { _Pragma("unroll") for (int m = 0; m < 4; ++m) _Pragma("unroll") for (int k = 0; k < 2; ++k) dst[m][k] = *(const LAS bf16x8*)(lds + PG8_SA(b, h) + aoff + m * 2048 + k * 1024); } \
        else { _Pragma("unroll") for (int m = 0; m < 4; ++m) dst##8[m] = PG8_LD8(lds + PG8_SA(b, h) + aoff + m * 2048); } } while (0)
#define PG8_LDB(dst, b, h) do { if constexpr (MODE == 0) { _Pragma("unroll") for (int n = 0; n < 2; ++n) _Pragma("unroll") for (int k = 0; k < 2; ++k) dst[n][k] = *(const LAS bf16x8*)(lds + PG8_SB(b, h) + boff + n * 2048 + k * 1024); } \
        else { _Pragma("unroll") for (int n = 0; n < 2; ++n) dst##8[n] = PG8_LD8(lds + PG8_SB(b, h) + boff + n * 2048); } } while (0)
#define PG8_MMA(ai, bj, At, Bt) do { __builtin_amdgcn_s_setprio(1); \
        if constexpr (MODE == 0) { _Pragma("unroll") for (int m = 0; m < 4; ++m) _Pragma("unroll") for (int n = 0; n < 2; ++n) _Pragma("unroll") for (int k = 0; k < 2; ++k) \
            acc[ai][bj][m][n] = __builtin_amdgcn_mfma_f32_16x16x32_bf16(Bt[n][k], At[m][k], acc[ai][bj][m][n], 0, 0, 0); } \
        else { _Pragma("unroll") for (int m = 0; m < 4; ++m) _Pragma("unroll") for (int n = 0; n < 2; ++n) \
            asm volatile("v_mfma_scale_f32_16x16x128_f8f6f4 %0, %1, %2, %0, %3, %4 op_sel_hi:[0,0,0]" : "+v"(acc[ai][bj][m][n]) : "v"(Bt##8[n]), "v"(At##8[m]), "v"(sclB), "v"(sclA)); } \
        __builtin_amdgcn_s_setprio(0); } while (0)
#define PG8_WAIT_V(n) asm volatile("s_waitcnt vmcnt(" #n ")" ::: "memory")
#define PG8_WAIT_L(n) asm volatile("s_waitcnt lgkmcnt(" #n ")" ::: "memory")
#define PG8_BAR __builtin_amdgcn_s_barrier()
#define PG8_SCHED __builtin_amdgcn_sched_barrier(0)
    Unit cur, nxt; int ui = 0;
    if constexpr (Sched::TABLES) S.setup(lds, tid);
    if (!S.next(0, cur)) return;
    f32x4 acc[2][2][4][2];
#pragma unroll
    for (int a = 0; a < 2; ++a)
#pragma unroll
        for (int b = 0; b < 2; ++b)
#pragma unroll
            for (int m = 0; m < 4; ++m)
#pragma unroll
                for (int n = 0; n < 2; ++n) acc[a][b][m][n] = (f32x4){0.f, 0.f, 0.f, 0.f};
    const int sclB = Epi::SCALE_B, sclA = 0x7F7F7F7F;
    bf16x8 At[4][2], B0[2][2], B1[2][2]; v8i32 At8[4], B08[2], B18[2];
    unsigned o00, o01, o10, o11;
    o00 = (unsigned)S.arow(cur, Rp[0]) * lda2 + Cp2[0]; o01 = (unsigned)S.arow(cur, Rp[1]) * lda2 + Cp2[1];
    o10 = (unsigned)S.arow(cur, HALF + Rp[0]) * lda2 + Cp2[0]; o11 = (unsigned)S.arow(cur, HALF + Rp[1]) * lda2 + Cp2[1];
    const char* cB = cur.B;
#define PG8_EPITAB(u, slot) do { if constexpr (Epi::NTAB > 0) { if (wid >= 1 && wid <= Epi::NTAB) \
        __builtin_amdgcn_global_load_lds((const unsigned*)(E.tab_src(wid - 1, (u)) + lane * 16), (LAS unsigned*)(lds + EPIT_OFF + (slot) * EPIT_SLOT + (wid - 1) * 1024), 16, 0, 0); } } while (0)
    PG8_EPITAB(cur, 0);
    PG8_STAGE_B(PG8_SB(0, 0), cB); PG8_STAGE_B(PG8_SB(0, 1), cB + hstepB); PG8_STAGE_A(PG8_SA(0, 0), o00, o01, 0); PG8_STAGE_A(PG8_SA(0, 1), o10, o11, 0);
    if (wr == 1) PG8_BAR;
    PG8_WAIT_V(2); PG8_BAR;
    PG8_STAGE_B(PG8_SB(1, 0), cB + 128); PG8_STAGE_A(PG8_SA(1, 0), o00, o01, 128); PG8_STAGE_B(PG8_SB(1, 1), cB + hstepB + 128);
    PG8_WAIT_V(6); PG8_BAR;
    for (;;) {
        const bool has_next = S.next(ui + 1, nxt);
        unsigned n00 = o00, n01 = o01, n10 = o10, n11 = o11; const char* nB = cB;
        if (has_next) { nB = nxt.B;
            if (Sched::GATHERS && ui > 0) {
                const LAS int* tb = (const LAS int*)(lds + ROWT_OFF + ((ui + 1) & 1) * 1024);
                const int t00 = tb[Rp[0]], t01 = tb[Rp[1]], t10 = tb[HALF + Rp[0]], t11 = tb[HALF + Rp[1]];
                n00 = (unsigned)(t00 < 0 ? 0 : (t00 >> 2)) * lda2 + Cp2[0]; n01 = (unsigned)(t01 < 0 ? 0 : (t01 >> 2)) * lda2 + Cp2[1];
                n10 = (unsigned)(t10 < 0 ? 0 : (t10 >> 2)) * lda2 + Cp2[0]; n11 = (unsigned)(t11 < 0 ? 0 : (t11 >> 2)) * lda2 + Cp2[1];
            } else { n00 = (unsigned)S.arow(nxt, Rp[0]) * lda2 + Cp2[0]; n01 = (unsigned)S.arow(nxt, Rp[1]) * lda2 + Cp2[1];
                n10 = (unsigned)S.arow(nxt, HALF + Rp[0]) * lda2 + Cp2[0]; n11 = (unsigned)S.arow(nxt, HALF + Rp[1]) * lda2 + Cp2[1]; } }
        if (has_next) PG8_EPITAB(nxt, (ui + 1) % 3);
        if constexpr (Sched::GATHERS) { const int pm2 = S.pm_of(ui + 2);
            if (pm2 >= 0 && wid == 0) __builtin_amdgcn_global_load_lds((const unsigned*)(S.rowtab(pm2) + lane * 4), (LAS unsigned*)(lds + ROWT_OFF + (ui & 1) * 1024), 16, 0, 0); }
        for (int t = 0; t < nt; t += 2) {
            const bool last = (t == nt - 2);
            const unsigned kb1 = (unsigned)(t + 1) * 128u, kb2 = last ? 0u : (unsigned)(t + 2) * 128u;
            const unsigned x00 = last ? n00 : o00, x01 = last ? n01 : o01, x10 = last ? n10 : o10, x11 = last ? n11 : o11;
            const char* b2 = last ? nB : cB + (size_t)(t + 2) * 128; const char* b3 = b2 + 128;
            PG8_LDB(B0, 0, 0); PG8_LDB(B1, 0, 1); PG8_SCHED; PG8_LDA(At, 0, 0); PG8_STAGE_A(PG8_SA(1, 1), o10, o11, kb1);
            PG8_WAIT_V(8); PG8_WAIT_L(0); PG8_BAR; PG8_MMA(0, 0, At, B0); PG8_MMA(0, 1, At, B1); PG8_BAR; PG8_SCHED;
            PG8_LDA(At, 0, 1); PG8_STAGE_B(PG8_SB(0, 0), b2); PG8_STAGE_B(PG8_SB(0, 1), b2 + hstepB); PG8_STAGE_A(PG8_SA(0, 0), x00, x01, kb2);
            PG8_WAIT_V(8); PG8_WAIT_L(0); PG8_BAR; PG8_MMA(1, 0, At, B0); PG8_MMA(1, 1, At, B1); PG8_BAR; PG8_SCHED;
            PG8_LDB(B0, 1, 0); PG8_LDB(B1, 1, 1); PG8_SCHED; PG8_LDA(At, 1, 0); PG8_STAGE_A(PG8_SA(0, 1), x10, x11, kb2);
            PG8_WAIT_V(8); PG8_WAIT_L(0); PG8_BAR; PG8_MMA(0, 0, At, B0); PG8_MMA(0, 1, At, B1); PG8_BAR; PG8_SCHED;
            PG8_LDA(At, 1, 1); PG8_STAGE_B(PG8_SB(1, 0), b3); PG8_STAGE_B(PG8_SB(1, 1), b3 + hstepB); PG8_STAGE_A(PG8_SA(1, 0), x00, x01, kb2 + 128u);
            PG8_WAIT_V(8); PG8_WAIT_L(0); PG8_BAR; PG8_MMA(1, 0, At, B0); PG8_MMA(1, 1, At, B1); PG8_BAR; PG8_SCHED;
        }
        if (wr == 0) PG8_BAR;
        if constexpr (MODE == 1) asm volatile("s_nop 15\n\ts_nop 15" ::: "memory");
        E(acc, cur, wr, wc, fr, fq, (const LAS unsigned char*)(lds + EPIT_OFF + (ui % 3) * EPIT_SLOT));
        if (!has_next) break;
#pragma unroll
        for (int a = 0; a < 2; ++a)
#pragma unroll
            for (int b = 0; b < 2; ++b)
#pragma unroll
                for (int m = 0; m < 4; ++m)
#pragma unroll
                    for (int n = 0; n < 2; ++n) acc[a][b][m][n] = (f32x4){0.f, 0.f, 0.f, 0.f};
        cur = nxt; cB = nB; o00 = n00; o01 = n01; o10 = n10; o11 = n11; ++ui;
        if (wr == 1) PG8_BAR;
    }
    PG8_WAIT_V(0);
    PG8_BAR;
#undef PG8_SA
#undef PG8_EPITAB
#undef PG8_SB
#undef PG8_STAGE_A
#undef PG8_STAGE_B
#undef PG8_LDA
#undef PG8_LDB
#undef PG8_MMA
#undef PG8_LD8
#undef PG8_WAIT_V
#undef PG8_WAIT_L
#undef PG8_BAR
#undef PG8_SCHED
}

template <int NN> struct DenseOrder {
    static constexpr int nM = MTOK / BM, nwg = nM * NN; static constexpr bool TABLES = false, GATHERS = false;
    __device__ __forceinline__ void setup(LAS unsigned char*, int) const {}
    __device__ __forceinline__ int pm_of(int) const { return -1; }
    __device__ __forceinline__ const int* rowtab(int) const { return nullptr; }
    int G, c, K; const char* Bt;
    __device__ __forceinline__ void init(int K_, const void* Bt_, int G_, int c_) { G = G_; c = c_; K = K_; Bt = (const char*)Bt_; }
    __device__ __forceinline__ bool next(int i, Unit& u) const {
        const int L = i * G + c; if (L >= nwg) return false;
        constexpr int q = nwg / NXCD; static_assert(nwg % NXCD == 0, "units divide over the XCDs");
        const int wgid = (L % NXCD) * q + L / NXCD;
        constexpr int nig = WGM * NN; const int gid = wgid / nig, fm = gid * WGM, rem = wgid % nig;
        u.pm = fm + (rem & (WGM - 1)); u.pn = rem / WGM; u.e = 0; u.B = Bt + (size_t)u.pn * BM * K * 2; return true;
    }
    __device__ __forceinline__ int arow(const Unit& u, int r) const { return u.pm * BM + r; }
};
template <int NT, bool GATHER> struct MoeOrder {
    static constexpr bool TABLES = true, GATHERS = GATHER;
    int G, c, K, mt_lo, nmt, esz; const int* mte; const int* tokrow; const char* Wt; size_t estride;
    LAS unsigned char* lds_;
    __device__ __forceinline__ void setup(LAS unsigned char* lds, int tid) { lds_ = lds; __syncthreads();
        for (int i = tid; i < nmt; i += 512) *(LAS int*)(lds + MTE_OFF + 4 * i) = mte[mt_lo + i];
        __syncthreads(); }
    __device__ __forceinline__ bool place(int i, int& pm, int& pn) const {
        const long L = (long)i * G + c; const int nwg = nmt * NT; if (L >= (long)nwg) return false;
        int wgid = (int)L; { const int q = nwg / NXCD, r = nwg % NXCD, xcd = wgid % NXCD, off = wgid / NXCD; wgid = (xcd < r ? xcd * (q + 1) : r * (q + 1) + (xcd - r) * q) + off; }
        constexpr int nig = WGM * NT; const int gid = wgid / nig, fm = gid * WGM, gsz = (nmt - fm) < WGM ? (nmt - fm) : WGM, rem = wgid % nig;
        if (gsz == WGM) { pm = mt_lo + fm + (rem & (WGM - 1)); pn = rem / WGM; } else { pm = mt_lo + fm + rem % gsz; pn = rem / gsz; }
        return true; }
    __device__ __forceinline__ bool next(int i, Unit& u) const {
        if (!place(i, u.pm, u.pn)) return false;
        const int e = __builtin_amdgcn_readfirstlane(*(const LAS int*)(lds_ + MTE_OFF + 4 * (u.pm - mt_lo)));
        u.e = e; u.B = Wt + (size_t)e * estride + (size_t)u.pn * BM * K * esz; return true;
    }
    __device__ __forceinline__ int pm_of(int i) const { int pm, pn; return place(i, pm, pn) ? pm : -1; }
    __device__ __forceinline__ const int* rowtab(int pm) const { return tokrow + (size_t)pm * BM; }
    __device__ __forceinline__ int arow(const Unit& u, int r) const { if (GATHER) { const int t = tokrow[u.pm * BM + r]; return t < 0 ? 0 : (t >> 2); } return (u.pm - mt_lo) * BM + r; }
};

struct EpiProj {
    static constexpr bool PERM = true; static constexpr int SCALE_B = 0x7F7F7F7F, NTAB = 0;
    bf16_t* O;
    __device__ __forceinline__ const char* tab_src(int, const Unit&) const { return nullptr; }
    __device__ __forceinline__ void operator()(const f32x4 (&acc)[2][2][4][2], const Unit& u, int wr, int wc, int fr, int fq, const LAS unsigned char*) const {
        const int row0 = u.pm * BM + wr * 64 + fr, col0 = u.pn * BM + wc * 32 + 8 * fq;
#pragma unroll
        for (int ai = 0; ai < 2; ++ai)
#pragma unroll
            for (int m = 0; m < 4; ++m) { bf16_t* rowp = O + (size_t)(row0 + ai * HALF + m * 16) * NP + col0;
#pragma unroll
                for (int bj = 0; bj < 2; ++bj) { const f32x4 v0 = acc[ai][bj][m][0], v1 = acc[ai][bj][m][1];
                    u32x4 w; w.x = pk2(v0[0], v0[1]); w.y = pk2(v0[2], v0[3]); w.z = pk2(v1[0], v1[1]); w.w = pk2(v1[2], v1[3]);
                    *(u32x4*)(rowp + bj * HALF) = w; } }
    }
};
struct EpiRes {
    static constexpr bool PERM = false; static constexpr int SCALE_B = 0x7F7F7F7F, NTAB = 0;
    const float* X; float* O;
    __device__ __forceinline__ const char* tab_src(int, const Unit&) const { return nullptr; }
    __device__ __forceinline__ void operator()(const f32x4 (&acc)[2][2][4][2], const Unit& u, int wr, int wc, int fr, int fq, const LAS unsigned char*) const {
        const int row0 = u.pm * BM + wr * 64 + fr, col0 = u.pn * BM + wc * 32 + 4 * fq;
#pragma unroll
        for (int ai = 0; ai < 2; ++ai) { f32x4 xv[4][2][2];
#pragma unroll
            for (int m = 0; m < 4; ++m) { const size_t off = (size_t)(row0 + ai * HALF + m * 16) * DM + col0;
#pragma unroll
                for (int bj = 0; bj < 2; ++bj)
#pragma unroll
                    for (int n = 0; n < 2; ++n) xv[m][bj][n] = *(const f32x4*)(X + off + bj * HALF + n * 16); }
            asm volatile("" ::: "memory");
#pragma unroll
            for (int m = 0; m < 4; ++m) { const size_t off = (size_t)(row0 + ai * HALF + m * 16) * DM + col0;
#pragma unroll
                for (int bj = 0; bj < 2; ++bj)
#pragma unroll
                    for (int n = 0; n < 2; ++n) *(f32x4*)(O + off + bj * HALF + n * 16) = acc[ai][bj][m][n] + xv[m][bj][n]; }
            asm volatile("" ::: "memory"); }
    }
};
__device__ __forceinline__ float swiglu1(float g, float l1) {
    g = fminf(g, 7.0f); l1 = __builtin_amdgcn_fmed3f(l1, -6.0f, 8.0f);
    const float sg = __builtin_amdgcn_rcpf(1.0f + __builtin_amdgcn_exp2f(-1.702f * LOG2E * g));
    return (g * sg) * l1;
}
struct EpiSwiglu {
    static constexpr bool PERM = true; static constexpr int SCALE_B = 0x7A7A7A7A, NTAB = 2;
    const float* b1; unsigned char* ACT; int mt_lo; const float* rrow;
    __device__ __forceinline__ const char* tab_src(int k, const Unit& u) const { return k == 0 ? (const char*)(b1 + (size_t)u.e * 2048 + u.pn * BM) : (const char*)(rrow + (size_t)u.pm * BM); }
    __device__ __forceinline__ void operator()(const f32x4 (&acc)[2][2][4][2], const Unit& u, int wr, int wc, int fr, int fq, const LAS unsigned char* tb) const {
        const int row0 = (u.pm - mt_lo) * BM + wr * 64 + fr, col0 = u.pn * BM + wc * 32 + 8 * fq;
        f32x4 bv[2][2];
#pragma unroll
        for (int bj = 0; bj < 2; ++bj)
#pragma unroll
            for (int n = 0; n < 2; ++n) { bv[bj][n] = *(const LAS f32x4*)(tb + (wc * 32 + 8 * fq + bj * HALF + 4 * n) * 4); bv[bj][n][1] += 1.0f; bv[bj][n][3] += 1.0f; }
        float rr[2][4];
#pragma unroll
        for (int ai = 0; ai < 2; ++ai)
#pragma unroll
            for (int m = 0; m < 4; ++m) rr[ai][m] = *(const LAS float*)(tb + 1024 + (wr * 64 + fr + ai * HALF + m * 16) * 4);
#pragma unroll
        for (int ai = 0; ai < 2; ++ai)
#pragma unroll
            for (int m = 0; m < 4; ++m) { unsigned char* rowp = ACT + (size_t)(row0 + ai * HALF + m * 16) * DFF + (col0 >> 1);
#pragma unroll
                for (int bj = 0; bj < 2; ++bj) { const f32x4 v0 = acc[ai][bj][m][0] * rr[ai][m] + bv[bj][0], v1 = acc[ai][bj][m][1] * rr[ai][m] + bv[bj][1];
                    *(unsigned*)(rowp + bj * (HALF / 2)) = pk4_fp8_nc(swiglu1(v0[0], v0[1]), swiglu1(v0[2], v0[3]), swiglu1(v1[0], v1[1]), swiglu1(v1[2], v1[3])); } }
    }
};
struct EpiMoeOut {
    static constexpr bool PERM = true; static constexpr int SCALE_B = 0x7A7A7A7A, NTAB = 3;
    const float* b2; const int* tokrow; const float* grow; unsigned char* Y;
    __device__ __forceinline__ const char* tab_src(int k, const Unit& u) const { return k == 0 ? (const char*)(b2 + (size_t)u.e * DM + u.pn * BM) : k == 1 ? (const char*)(tokrow + (size_t)u.pm * BM) : (const char*)(grow + (size_t)u.pm * BM); }
    __device__ __forceinline__ void operator()(const f32x4 (&acc)[2][2][4][2], const Unit& u, int wr, int wc, int fr, int fq, const LAS unsigned char* tb) const {
        const int col0 = u.pn * BM + wc * 32 + 8 * fq;
        f32x4 bv[2][2];
#pragma unroll
        for (int bj = 0; bj < 2; ++bj)
#pragma unroll
            for (int n = 0; n < 2; ++n) bv[bj][n] = *(const LAS f32x4*)(tb + (wc * 32 + 8 * fq + bj * HALF + 4 * n) * 4);
        int tk[2][4]; float gg[2][4];
#pragma unroll
        for (int ai = 0; ai < 2; ++ai)
#pragma unroll
            for (int m = 0; m < 4; ++m) { const int rl = wr * 64 + fr + ai * HALF + m * 16; tk[ai][m] = *(const LAS int*)(tb + 1024 + rl * 4); gg[ai][m] = *(const LAS float*)(tb + 2048 + rl * 4); }
#pragma unroll
        for (int ai = 0; ai < 2; ++ai)
#pragma unroll
            for (int m = 0; m < 4; ++m) { const float g = gg[ai][m];
                if (tk[ai][m] >= 0) { unsigned char* yp = Y + (size_t)tk[ai][m] * DM + col0; const float g16 = g * 16.0f;
#pragma unroll
                    for (int bj = 0; bj < 2; ++bj) { const f32x4 v0 = (acc[ai][bj][m][0] + bv[bj][0]) * g16, v1 = (acc[ai][bj][m][1] + bv[bj][1]) * g16;
                        u32x2 w; w.x = pk4_fp8(v0[0], v0[1], v0[2], v0[3]); w.y = pk4_fp8(v1[0], v1[1], v1[2], v1[3]);
                        *(u32x2*)(yp + bj * HALF) = w; } } }
    }
};
}

#define XB_TMO      128
#define XB_XCNT(j)  (256  + 64 * (j))
#define XB_XSUB(j)  (1280 + 64 * (j))
#define XB_XGEN(j)  (2304 + 64 * (j))
#define XB_TOP      3328
#define XB_TOPGEN   3392
#define XCD_BAR_WORDS 3456
#define XB_SPIN_CAP (1u << 26)

__device__ __forceinline__ unsigned xb_ld(unsigned* p)              { return __hip_atomic_load(p, __ATOMIC_RELAXED, __HIP_MEMORY_SCOPE_AGENT); }
__device__ __forceinline__ unsigned xb_add(unsigned* p, unsigned v) { return __hip_atomic_fetch_add(p, v, __ATOMIC_RELAXED, __HIP_MEMORY_SCOPE_AGENT); }
__device__ __forceinline__ unsigned xb_xcc_id() { return (unsigned)__builtin_amdgcn_s_getreg((3 << 11) | 20) & 0xFu; }
#define XB_SPIN(cond, bar) do { unsigned _sp = 0; while (cond) { __builtin_amdgcn_s_sleep(1); \
    if ((++_sp & 255u) == 0u) { if (xb_ld(&(bar)[XB_TMO])) break; if (_sp > XB_SPIN_CAP) { atomicAdd(&(bar)[XB_TMO], 1u); break; } } } } while (0)
struct XcdBarrier { unsigned* bar; unsigned x; volatile LAS unsigned* st; };
__device__ __forceinline__ XcdBarrier xcd_barrier_post(unsigned* bar, volatile LAS unsigned* st) {
    XcdBarrier b; b.bar = bar; b.x = xb_xcc_id(); b.st = st;
    if (threadIdx.x == 0) (void)xb_add(&bar[XB_XCNT(b.x)], 1u);
    return b;
}
__device__ __forceinline__ void xcd_barrier_complete(unsigned* bar, unsigned x, unsigned& nloc, unsigned& nx) {
    const unsigned G = gridDim.x * gridDim.y * gridDim.z;
    unsigned sum, cnt, mine, sp = 0u;
    for (;;) {
        sum = 0u; cnt = 0u; mine = 0u;
#pragma unroll
        for (unsigned j = 0; j < 16; ++j) { const unsigned c = xb_ld(&bar[XB_XCNT(j)]); sum += c; cnt += (c > 0u) ? 1u : 0u; mine = (j == x) ? c : mine; }
        if (sum == G) break;
        __builtin_amdgcn_s_sleep(1);
        if ((++sp & 255u) == 0u) { if (xb_ld(&bar[XB_TMO])) break; if (sp > XB_SPIN_CAP) { atomicAdd(&bar[XB_TMO], 1u); break; } }
    }
    nloc = mine > 0u ? mine : 1u; nx = cnt > 0u ? cnt : 1u;
}
__device__ __forceinline__ void xcd_barrier(const XcdBarrier& b) {
    asm volatile("s_waitcnt vmcnt(0)" ::: "memory");
    __syncthreads();
    if (threadIdx.x == 0) {
        unsigned* bar = b.bar;
        __builtin_amdgcn_s_waitcnt(0);
        unsigned nloc = b.st[0], nx = b.st[1];
        if (nloc == 0u) { xcd_barrier_complete(bar, b.x, nloc, nx); b.st[0] = nloc; b.st[1] = nx; }
        const unsigned old = xb_add(&bar[XB_XSUB(b.x)], 1u);
        const unsigned gen = old / nloc;
        if (old + 1u == (gen + 1u) * nloc) {
            __builtin_amdgcn_fence(__ATOMIC_RELEASE, "agent");
            asm volatile("s_waitcnt vmcnt(0)" ::: "memory");
            const unsigned og = xb_add(&bar[XB_TOP], 1u);
            const unsigned tg = og / nx;
            if (og + 1u == (tg + 1u) * nx) xb_add(&bar[XB_TOPGEN], 1u);
            else XB_SPIN(xb_ld(&bar[XB_TOPGEN]) == tg, bar);
            __builtin_amdgcn_fence(__ATOMIC_ACQUIRE, "agent");
            xb_add(&bar[XB_XGEN(b.x)], 1u);
            asm volatile("s_waitcnt vmcnt(0)" ::: "memory");
        } else {
            XB_SPIN(xb_ld(&bar[XB_XGEN(b.x)]) == gen, bar);
            __builtin_amdgcn_fence(__ATOMIC_ACQUIRE, "agent");
            asm volatile("s_waitcnt vmcnt(0)" ::: "memory");
        }
    }
    __syncthreads();
}

struct Args { const float* in[16]; float* out; unsigned char* ws; int ph_lo, ph_hi; };
struct Frame {
    LAS unsigned char* lds;
    int tid, lane, wave, G;
    unsigned char* ws;
    const __attribute__((address_space(4))) Args* ap;
    float* out;
};
#define FIN(k) ((const float*)(const GAS float*)(F.ap->in[k]))
#define Fx FIN(0)
#define Fg1 FIN(1)
#define Fw_in FIN(2)
#define Frel_bias FIN(3)
#define Fkg FIN(4)
#define Fkb FIN(5)
#define Fgn FIN(6)
#define Fw_out FIN(7)
#define Fg2 FIN(8)
#define Fw_router FIN(9)
#define Fb_router FIN(10)
#define Fw1 FIN(11)
#define Fb1 FIN(12)
#define Fw2 FIN(13)
#define Fb2 FIN(14)
#define Fgf FIN(15)

__device__ __forceinline__ int win_src_col(int n) {
    if (n < 512) return n;
    if (n < 1024) return 2632 + (n - 512);
    if (n < 1536) return 512 + (n - 1024);
    if (n < 2048) return 1024 + (n - 1536);
    if (n < 2560) return 1536 + (n - 2048);
    if (n < 2816) return 2120 + (n - 2560);
    if (n < 3072) return 2376 + (n - 2816);
    if (n < 3584) return 3144 + (n - 3072);
    if (n < 3648) return 2048 + (n - 3584);
    if (n < 3656) return 2112 + (n - 3648);
    return -1;
}
__device__ __forceinline__ void tr_item(const float* W, int ldw, int K, bf16_t* WT, LAS float* scr, int k0, int n0, int lane, int sc, float scale) {
    float tv[32];
#pragma unroll
    for (int i = 0; i < 32; ++i) { const int kk = 2 * i + (lane >> 5); tv[i] = sc >= 0 ? W[(size_t)(k0 + kk) * ldw + sc] * scale : 0.f; }
#pragma unroll
    for (int i = 0; i < 32; ++i) { const int kk = 2 * i + (lane >> 5); scr[kk * 33 + (lane & 31)] = tv[i]; }
    LDS_WAIT(); asm volatile("" ::: "memory");
    const int c = lane & 7;
#pragma unroll
    for (int j = 0; j < 4; ++j) { const int n = (lane >> 3) + 8 * j; const LAS float* s = scr + (8 * c) * 33 + n;
        u32x4 o; o.x = pk2(s[0 * 33], s[1 * 33]); o.y = pk2(s[2 * 33], s[3 * 33]); o.z = pk2(s[4 * 33], s[5 * 33]); o.w = pk2(s[6 * 33], s[7 * 33]);
        *(u32x4*)(WT + (size_t)(n0 + n) * K + k0 + 8 * c) = o; }
    LDS_WAIT(); asm volatile("" ::: "memory");
}
__device__ __forceinline__ void tr_item_f8x2(const float* W, int ldw, int K, unsigned char* WT, LAS float* scr, int k0, int n0, int lane, float scale) {
    float tv[2][32];
#pragma unroll
    for (int t = 0; t < 2; ++t)
#pragma unroll
        for (int i = 0; i < 32; ++i) { const int kk = 2 * i + (lane >> 5); tv[t][i] = W[(size_t)(k0 + kk) * ldw + n0 + 32 * t + (lane & 31)] * scale; }
#pragma unroll
    for (int t = 0; t < 2; ++t) {
#pragma unroll
        for (int i = 0; i < 32; ++i) { const int kk = 2 * i + (lane >> 5); scr[kk * 33 + (lane & 31)] = tv[t][i]; }
        LDS_WAIT(); asm volatile("" ::: "memory");
        const int c = lane & 7;
#pragma unroll
        for (int j = 0; j < 4; ++j) { const int n = (lane >> 3) + 8 * j; const LAS float* sp = scr + (8 * c) * 33 + n;
            u32x2 o; o.x = pk4_fp8(sp[0 * 33], sp[1 * 33], sp[2 * 33], sp[3 * 33]); o.y = pk4_fp8(sp[4 * 33], sp[5 * 33], sp[6 * 33], sp[7 * 33]);
            *(u32x2*)(WT + (size_t)(n0 + 32 * t + n) * K + k0 + 8 * c) = o; }
        LDS_WAIT(); asm volatile("" ::: "memory"); }
}
__device__ __forceinline__ void rms_row_to_bf16(const float* xrow, const float* gain, bf16_t* orow, int lane) {
    const f32x4* xr = (const f32x4*)xrow + lane; const f32x4* gr = (const f32x4*)gain + lane;
    f32x4 v[4]; float s = 0.f;
#pragma unroll
    for (int j = 0; j < 4; ++j) { v[j] = xr[64 * j]; s += (v[j].x * v[j].x + v[j].y * v[j].y) + (v[j].z * v[j].z + v[j].w * v[j].w); }
    const float r = rsqrtf(wave_sum(s) * (1.f / DM) + 1e-5f);
    unsigned long long* o8 = (unsigned long long*)orow + lane;
#pragma unroll
    for (int j = 0; j < 4; ++j) { const f32x4 g = gr[64 * j]; o8[64 * j] = (unsigned long long)pk2(v[j].x * r * g.x, v[j].y * r * g.y) | ((unsigned long long)pk2(v[j].z * r * g.z, v[j].w * r * g.w) << 32); }
}
__device__ __forceinline__ void p0_prologue(Frame& F) {
    LAS float* scr = (LAS float*)(F.lds + F.wave * 16384);
    const int gw = blockIdx.x * 8 + F.wave, NGW = F.G * 8;
    bf16_t* WinT = (bf16_t*)(F.ws + WS_WIN); bf16_t* WoutT = (bf16_t*)(F.ws + WS_WOUT);
    constexpr int I_IN = 16 * (NP / 32), I_OUT = 16 * 32;
    for (int it = gw; it < I_IN + I_OUT; it += NGW) {
        if (it < I_IN) { const int kb = it / (NP / 32), nb = it % (NP / 32); const int n = nb * 32 + (F.lane & 31);
            tr_item(Fw_in, 3656, DM, WinT, scr, kb * 64, nb * 32, F.lane, win_src_col(n), n < 512 ? QA_SCALE : 1.0f); }
        else { const int r = it - I_IN; const int kb = r / 32, nb = r % 32; tr_item(Fw_out, DM, DM, WoutT, scr, kb * 64, nb * 32, F.lane, nb * 32 + (F.lane & 31), 1.0f); }
    }
    { bf16_t* WRH = (bf16_t*)(F.ws + WS_WRH); bf16_t* WRL = (bf16_t*)(F.ws + WS_WRL);
      for (int i = blockIdx.x * 512 + F.tid; i < 64 * 64 * 8; i += F.G * 512) { const int j = i & 7, ln = (i >> 3) & 63, kk = i >> 9; const int d = 16 * kk + 8 * (ln >> 5) + j, e = ln & 31;
          const float v = Fg2[d] * Fw_router[d * 32 + e]; const bf16_t hi = f2bf(v); WRH[i] = hi; WRL[i] = f2bf(v - bf2f(hi)); } }
    bf16_t* H = (bf16_t*)(F.ws + WS_H);
    for (int m = gw; m < MTOK; m += 2 * NGW) {
        const int m2 = m + NGW; const float* g1p = Fg1;
        const f32x4* xa = (const f32x4*)(Fx + (size_t)m * DM) + F.lane; const f32x4* xb = (const f32x4*)(Fx + (size_t)(m2 < MTOK ? m2 : m) * DM) + F.lane; const f32x4* gr = (const f32x4*)g1p + F.lane;
        f32x4 va[4], vb[4]; float sa = 0.f, sb = 0.f;
#pragma unroll
        for (int j = 0; j < 4; ++j) { va[j] = xa[64 * j]; vb[j] = xb[64 * j]; }
#pragma unroll
        for (int j = 0; j < 4; ++j) { sa += (va[j].x * va[j].x + va[j].y * va[j].y) + (va[j].z * va[j].z + va[j].w * va[j].w); sb += (vb[j].x * vb[j].x + vb[j].y * vb[j].y) + (vb[j].z * vb[j].z + vb[j].w * vb[j].w); }
        const float ra = rsqrtf(wave_sum(sa) * (1.f / DM) + 1e-5f), rb = rsqrtf(wave_sum(sb) * (1.f / DM) + 1e-5f);
        unsigned long long* oa = (unsigned long long*)(H + (size_t)m * DM) + F.lane; unsigned long long* ob = (unsigned long long*)(H + (size_t)(m2 < MTOK ? m2 : m) * DM) + F.lane;
#pragma unroll
        for (int j = 0; j < 4; ++j) { const f32x4 g = gr[64 * j];
            oa[64 * j] = (unsigned long long)pk2(va[j].x * ra * g.x, va[j].y * ra * g.y) | ((unsigned long long)pk2(va[j].z * ra * g.z, va[j].w * ra * g.w) << 32);
            if (m2 < MTOK) ob[64 * j] = (unsigned long long)pk2(vb[j].x * rb * g.x, vb[j].y * rb * g.y) | ((unsigned long long)pk2(vb[j].z * rb * g.z, vb[j].w * rb * g.w) << 32); }
    }
}

__device__ __forceinline__ float ret_log2g(int h) { return log2f(1.0f - exp2f(-5.0f - (float)h)); }
__device__ __forceinline__ int tsw(int row, int tok) { return row * 72 + ((((tok >> 3) ^ ((row >> 3) & 7)) << 3) | (tok & 7)); }
__device__ __forceinline__ void prep_phase(Frame& F) {
    LAS bf16_t* TK = (LAS bf16_t*)(F.lds);
    LAS bf16_t* TV = (LAS bf16_t*)(F.lds + 36864);
    const bf16_t* proj = (const bf16_t*)(F.ws + WS_PROJ);
    bf16_t* kiln = (bf16_t*)(F.ws + WS_KILN); float* wbuf = (float*)(F.ws + WS_WBUF);
    bf16_t* qr = (bf16_t*)(F.ws + WS_QR); bf16_t* kr = (bf16_t*)(F.ws + WS_KR); bf16_t* kTz = (bf16_t*)(F.ws + WS_KTZ);
    bf16_t* vTa = (bf16_t*)(F.ws + WS_VTA); bf16_t* vTb = (bf16_t*)(F.ws + WS_VTB);
    const int tid = F.tid, lane = F.lane;
    LAS f32x2* SC = (LAS f32x2*)(F.lds + 36864 + 73728);
    const int lt = tid >> 3, ls = tid & 7;
    float kgv[8], kbv[8];
    { const f32x4 g0 = *(const f32x4*)(Fkg + 8 * ls), g1 = *(const f32x4*)(Fkg + 8 * ls + 4), b0 = *(const f32x4*)(Fkb + 8 * ls), b1 = *(const f32x4*)(Fkb + 8 * ls + 4);
      kgv[0] = g0.x; kgv[1] = g0.y; kgv[2] = g0.z; kgv[3] = g0.w; kgv[4] = g1.x; kgv[5] = g1.y; kgv[6] = g1.z; kgv[7] = g1.w;
      kbv[0] = b0.x; kbv[1] = b0.y; kbv[2] = b0.z; kbv[3] = b0.w; kbv[4] = b1.x; kbv[5] = b1.y; kbv[6] = b1.z; kbv[7] = b1.w; }
    float lgh[4];
#pragma unroll
    for (int h = 0; h < 4; ++h) lgh[h] = ret_log2g(h);
    for (int u = blockIdx.x; u < NB * 128; u += F.G) {
        const int b = u >> 7, c = u & 127; const int tok0 = b * SEQ + c * 64;
        for (int i = 0; i < 4; ++i) { const int idx = tid + 512 * i, tl = idx >> 5, j = idx & 31; const int pos = c * 64 + tl;
            const float inv = exp2f(-(float)j * (13.287712379549449f / 31.0f)); const float ang = (float)pos * inv;
            double t = (double)ang * 0.15915494309189535; t -= rint(t); const float tf = (float)t;
            SC[idx] = (f32x2){__builtin_amdgcn_cosf(tf), __builtin_amdgcn_sinf(tf)}; }
        { const int tok = tok0 + lt; const bf16_t* pr = proj + (size_t)tok * NP;
          const u32x4 kv = *(const u32x4*)(pr + C_KI + 8 * ls); const unsigned kw[4] = {kv.x, kv.y, kv.z, kv.w};
          float xv[8]; float sm = 0.f;
#pragma unroll
          for (int e = 0; e < 4; ++e) { xv[2 * e] = __uint_as_float(kw[e] << 16); xv[2 * e + 1] = __uint_as_float(kw[e] & 0xffff0000u); sm += xv[2 * e] + xv[2 * e + 1]; }
          sm += __shfl_xor(sm, 1); sm += __shfl_xor(sm, 2); sm += __shfl_xor(sm, 4); const float mean = sm * (1.f / 64.f); float sq = 0.f;
#pragma unroll
          for (int e = 0; e < 8; ++e) { xv[e] -= mean; sq += xv[e] * xv[e]; }
          sq += __shfl_xor(sq, 1); sq += __shfl_xor(sq, 2); sq += __shfl_xor(sq, 4); const float rs = rsqrtf(sq * (1.f / 64.f) + 1e-6f);
          u32x4 o; o.x = pk2(xv[0] * rs * kgv[0] + kbv[0], xv[1] * rs * kgv[1] + kbv[1]); o.y = pk2(xv[2] * rs * kgv[2] + kbv[2], xv[3] * rs * kgv[3] + kbv[3]);
          o.z = pk2(xv[4] * rs * kgv[4] + kbv[4], xv[5] * rs * kgv[5] + kbv[5]); o.w = pk2(xv[6] * rs * kgv[6] + kbv[6], xv[7] * rs * kgv[7] + kbv[7]);
          const int tb = tok & (SEQ - 1);
          *(u32x4*)(kiln + (size_t)(tok - tb) * 64 + ((size_t)((tb >> 5) * 4 + (ls >> 1)) * 64 + (tb & 31) + 32 * (ls & 1)) * 8) = o;
          if (ls == 0) { const u32x4 wv4 = *(const u32x4*)(pr + C_WI); f32x4 w0, w1; w0.x = __uint_as_float(wv4.x << 16) * IDX_W_SCALE; w0.y = __uint_as_float(wv4.x & 0xffff0000u) * IDX_W_SCALE; w0.z = __uint_as_float(wv4.y << 16) * IDX_W_SCALE; w0.w = __uint_as_float(wv4.y & 0xffff0000u) * IDX_W_SCALE;
              w1.x = __uint_as_float(wv4.z << 16) * IDX_W_SCALE; w1.y = __uint_as_float(wv4.z & 0xffff0000u) * IDX_W_SCALE; w1.z = __uint_as_float(wv4.w << 16) * IDX_W_SCALE; w1.w = __uint_as_float(wv4.w & 0xffff0000u) * IDX_W_SCALE;
              *(f32x4*)(wbuf + (size_t)tok * 8) = w0; *(f32x4*)(wbuf + (size_t)tok * 8 + 4) = w1; } }
        __syncthreads();
        u32x4 ra[4], rb[4];
#pragma unroll
        for (int i = 0; i < 4; ++i) { const int id = tid + 512 * i, which = id >> 10, rem = id & 1023, tl = rem >> 4, hq = rem & 15;
            const bf16_t* pr = proj + (size_t)(tok0 + tl) * NP + (which ? C_KB : C_QB) + (hq >> 2) * 64 + 8 * (hq & 3); ra[i] = *(const u32x4*)(pr); rb[i] = *(const u32x4*)(pr + 32); }
#pragma unroll
        for (int i = 0; i < 4; ++i) { const int id = tid + 512 * i, which = id >> 10, rem = id & 1023, tl = rem >> 4, hq = rem & 15, h = hq >> 2, jg = hq & 3;
            const unsigned aw[4] = {ra[i].x, ra[i].y, ra[i].z, ra[i].w}, bw[4] = {rb[i].x, rb[i].y, rb[i].z, rb[i].w};
            float o1[8], o2[8];
#pragma unroll
            for (int e = 0; e < 8; ++e) { const float x1 = (e & 1) ? __uint_as_float(aw[e >> 1] & 0xffff0000u) : __uint_as_float(aw[e >> 1] << 16), x2 = (e & 1) ? __uint_as_float(bw[e >> 1] & 0xffff0000u) : __uint_as_float(bw[e >> 1] << 16);
                const f32x2 cs = SC[tl * 32 + 8 * jg + e]; const float sc = which ? 0.125f : 1.0f;
                o1[e] = (x1 * cs.x - x2 * cs.y) * sc; o2[e] = (x2 * cs.x + x1 * cs.y) * sc; }
            bf16_t* dst = (which ? kr : qr) + (size_t)(tok0 + tl) * 256 + h * 64 + 8 * jg;
            u32x4 w1; w1.x = pk2(o1[0], o1[1]); w1.y = pk2(o1[2], o1[3]); w1.z = pk2(o1[4], o1[5]); w1.w = pk2(o1[6], o1[7]);
            u32x4 w2; w2.x = pk2(o2[0], o2[1]); w2.y = pk2(o2[2], o2[3]); w2.z = pk2(o2[4], o2[5]); w2.w = pk2(o2[6], o2[7]);
            *(u32x4*)(dst) = w1; *(u32x4*)(dst + 32) = w2;
            if (which) { const float z = exp2f((float)(63 - tl) * lgh[h]);
#pragma unroll
                for (int e = 0; e < 8; ++e) { TK[tsw(h * 64 + 8 * jg + e, tl)] = f2bf(o1[e] * z); TK[tsw(h * 64 + 8 * jg + e + 32, tl)] = f2bf(o2[e] * z); } } }
        __syncthreads();
        { const int row = tid >> 1, hf = tid & 1;
#pragma unroll
          for (int i = 0; i < 4; ++i) { const u32x4 v = *(const LAS u32x4*)(TK + tsw(row, hf * 32 + i * 8)); *(u32x4*)(kTz + (size_t)(b * 256 + row) * SEQ + c * 64 + hf * 32 + i * 8) = v; } }
        for (int which = 1; which < 2; ++which) {
            __syncthreads();
            const int colbase = which ? C_VB : C_VA;
            for (int i = 0; i < 8; ++i) { const int p = tid + 512 * i, tl = p >> 6, seg = p & 63; const u32x4 v = *(const u32x4*)(proj + (size_t)(tok0 + tl) * NP + colbase + seg * 8);
                const unsigned w4[4] = {v.x, v.y, v.z, v.w};
#pragma unroll
                for (int e = 0; e < 4; ++e) { TV[tsw(seg * 8 + 2 * e, tl)] = (bf16_t)(w4[e] & 0xffffu); TV[tsw(seg * 8 + 2 * e + 1, tl)] = (bf16_t)(w4[e] >> 16); } }
            __syncthreads();
            bf16_t* dst = which ? vTb : vTa;
            for (int i = 0; i < 8; ++i) { const int p = tid + 512 * i, row = p >> 3, sg = p & 7; const u32x4 v = *(const LAS u32x4*)(TV + tsw(row, sg * 8));
                *(u32x4*)(dst + (size_t)(b * 512 + row) * SEQ + c * 64 + sg * 8) = v; }
            { const int h = F.wave >> 1, l31 = lane & 31, hf = lane >> 5; bf16_t* KVo = (bf16_t*)(F.ws + WS_KV) + ((size_t)((b * 4 + h) * 128 + c) * 128) * 64;
              bf16x8 bfr[2][4];
#pragma unroll
              for (int nt = 0; nt < 2; ++nt)
#pragma unroll
                  for (int kk = 0; kk < 4; ++kk) bfr[nt][kk] = *(const LAS bf16x8*)(TK + tsw(h * 64 + 32 * nt + l31, 16 * kk + 8 * hf));
#pragma unroll
              for (int m2 = 0; m2 < 2; ++m2) { const int mt = (F.wave & 1) * 2 + m2; bf16x8 afr[4];
#pragma unroll
                  for (int kk = 0; kk < 4; ++kk) afr[kk] = *(const LAS bf16x8*)(TV + tsw(h * 128 + 32 * mt + l31, 16 * kk + 8 * hf));
#pragma unroll
                  for (int nt = 0; nt < 2; ++nt) { f32x16 acc = {};
#pragma unroll
                      for (int kk = 0; kk < 4; ++kk) acc = __builtin_amdgcn_mfma_f32_32x32x16_bf16(afr[kk], bfr[nt][kk], acc, 0, 0, 0);
                      int lofs = 4 * hf * 64 + l31; asm volatile("" : "+v"(lofs)); bf16_t* op = KVo + lofs;
#pragma unroll
                      for (int a = 0; a < 16; ++a) op[(32 * mt + crow(a, 0)) * 64 + 32 * nt] = f2bf(acc[a]); } } }
        }
        __syncthreads();
    }
}

constexpr int ICAP = 896, ICJ = ICAP / 64;
__device__ __forceinline__ unsigned compact_top(LAS unsigned* buf, int n, int lane, int target) {
    unsigned x[ICJ];
#pragma unroll
    for (int j = 0; j < ICJ; ++j) x[j] = buf[lane + 64 * j];
    unsigned a = ~0u, o = 0u;
#pragma unroll
    for (int j = 0; j < ICJ; ++j) { const bool in = (lane + 64 * j) < n; x[j] = in ? x[j] : 0u; a &= in ? x[j] : ~0u; o |= x[j]; }
#pragma unroll
    for (int sft = 1; sft < 64; sft <<= 1) { a &= (unsigned)__shfl_xor((int)a, sft); o |= (unsigned)__shfl_xor((int)o, sft); }
    int bit = 31 - __clz((int)((a ^ o) | 1u));
    unsigned P = (bit >= 31) ? 0u : (a & ~((2u << bit) - 1u));
    for (; bit >= 0; --bit) { const unsigned T = P | (1u << bit); int c = 0;
#pragma unroll
        for (int j = 0; j < ICJ; ++j) c += __popcll(__ballot(x[j] >= T));
        if (c >= target) { P = T; if (c == target) break; } }
    int base = 0;
#pragma unroll
    for (int j = 0; j < ICJ; ++j) { const bool k = x[j] >= P; const unsigned long long mk = __ballot(k); const int pos = base + (int)__builtin_amdgcn_mbcnt_hi((unsigned)(mk >> 32), __builtin_amdgcn_mbcnt_lo((unsigned)mk, 0u));
        if (k) buf[pos] = x[j]; base += __popcll(mk); }
    LDS_WAIT();
    return P;
}
template <int NJ> __device__ __forceinline__ void select_bits(const LAS unsigned* buf, int n, int lane, LAS unsigned* MASK, unsigned qbit) {
    unsigned x[NJ];
#pragma unroll
    for (int j = 0; j < NJ; ++j) x[j] = buf[lane + 64 * j];
    unsigned a = ~0u, o = 0u;
#pragma unroll
    for (int j = 0; j < NJ; ++j) { const bool in = (lane + 64 * j) < n; x[j] = in ? x[j] : 0u; a &= in ? x[j] : ~0u; o |= x[j]; }
    unsigned P = 0u;
    if (n > 256) {
#pragma unroll
        for (int sft = 1; sft < 64; sft <<= 1) { a &= (unsigned)__shfl_xor((int)a, sft); o |= (unsigned)__shfl_xor((int)o, sft); }
        int bit = 31 - __clz((int)((a ^ o) | 1u));
        P = (bit >= 31) ? 0u : (a & ~((2u << bit) - 1u));
        for (; bit >= 0; --bit) { const unsigned T = P | (1u << bit); int c = 0;
#pragma unroll
            for (int j = 0; j < NJ; ++j) c += __popcll(__ballot(x[j] >= T));
            if (c >= 256) { P = T; if (c == 256) break; } } }
    P = P ? P : 1u;
#pragma unroll
    for (int j = 0; j < NJ; ++j) if (x[j] >= P) { const int kidx = 8191 - (int)(x[j] & 0x1FFFu);
        const int key = kidx & 63, wq = 16 * ((key >> 5) & 1) + (key & 3) + 4 * ((key >> 3) & 3), hb = (key >> 2) & 1;
        __hip_atomic_fetch_or(MASK + ((kidx >> 6) * 32 + wq) * 2 + hb, qbit, __ATOMIC_RELAXED, __HIP_MEMORY_SCOPE_WORKGROUP); }
}
__device__ __forceinline__ float relu1(float x) { const int xi = __float_as_int(x); return __int_as_float(xi > 0 ? xi : 0); }
__device__ __forceinline__ void index_phase(Frame& F) {
    LAS unsigned* CAND = (LAS unsigned*)(F.lds);
    LAS unsigned* MASK = (LAS unsigned*)(F.lds + 32 * ICAP * 4);
    LAS unsigned* TRASH = (LAS unsigned*)(F.lds + 32 * ICAP * 4 + 32768);
    const bf16_t* proj = (const bf16_t*)(F.ws + WS_PROJ); const bf16_t* kiln = (const bf16_t*)(F.ws + WS_KILN); const float* wbuf = (const float*)(F.ws + WS_WBUF);
    unsigned* maskg = (unsigned*)(F.ws + WS_MASK);
    const int tid = F.tid, lane = F.lane, wave = F.wave, kcol = lane & 31, hf = lane >> 5;
    bf16x8 afn[4]; f32x4 wvn[2][2];
    auto unit_of = [&](int i) { return (i & 1) ? i * F.G + (F.G - 1 - (int)blockIdx.x) : i * F.G + (int)blockIdx.x; };
    auto request = [&](int r) __attribute__((always_inline)) { const int c = 127 - (r >> 4), b = (r & 15) >> 1, half = r & 1; const int q0 = b * SEQ + c * 64 + half * 32;
        const int m = kcol; const int ql = 2 * ((m >> 2) & 1) + (m >> 4), hd = 4 * ((m >> 3) & 1) + (m & 3);
        const bf16_t* qrow = proj + (size_t)(q0 + 4 * wave + ql) * NP + C_QI + hd * 64 + hf * 8;
#pragma unroll
        for (int kk = 0; kk < 4; ++kk) afn[kk] = *(const bf16x8*)(qrow + 16 * kk);
#pragma unroll
        for (int e = 0; e < 2; ++e) { const f32x4* wp = (const f32x4*)(wbuf + (size_t)(q0 + 4 * wave + 2 * hf + e) * 8); wvn[e][0] = wp[0]; wvn[e][1] = wp[1]; } };
    if (unit_of(0) < NB * 128 * 2) request(unit_of(0));
    for (int i = 0;; ++i) {
        const int r = unit_of(i);
        if (r >= NB * 128 * 2) break;
        const int c = 127 - (r >> 4), b = (r & 15) >> 1, half = r & 1;
        const int L = (c + 1) * 64; const int q0 = b * SEQ + c * 64 + half * 32;
        __syncthreads();
        for (int j = tid; j < 128 * 64; j += 512) MASK[j] = 0u;
        bf16x8 af[4];
#pragma unroll
        for (int kk = 0; kk < 4; ++kk) af[kk] = afn[kk];
        float wv[2][8];
#pragma unroll
        for (int e = 0; e < 2; ++e) { const f32x4 a = wvn[e][0], bq = wvn[e][1];
            wv[e][0] = a.x; wv[e][1] = a.y; wv[e][2] = a.z; wv[e][3] = a.w; wv[e][4] = bq.x; wv[e][5] = bq.y; wv[e][6] = bq.z; wv[e][7] = bq.w; }
        unsigned cnt[4], thr[4];
        const bf16_t* kp = kiln + (size_t)(b * SEQ) * 64 + lane * 8;
        const int nsub = L >> 5, ngrp = (nsub + 3) >> 2;
        bf16x8 bc[4][4], bn[4][4];
        for (int pass = 0; pass < 2; ++pass) {
        unsigned firstmask = 0xFu, guessed = 0u;
#pragma unroll
        for (int q = 0; q < 4; ++q) { cnt[q] = 0u; thr[q] = 0u; }
#pragma unroll
        for (int s2 = 0; s2 < 4; ++s2) { const int sn = s2 < nsub ? s2 : nsub - 1;
#pragma unroll
            for (int kk = 0; kk < 4; ++kk) bc[s2][kk] = *(const bf16x8*)(kp + (size_t)(sn * 4 + kk) * 512); }
        for (int g = 0; g < ngrp; ++g) {
#pragma unroll
            for (int s2 = 0; s2 < 4; ++s2) { int sn = (g + 1) * 4 + s2; sn = sn < nsub ? sn : nsub - 1;
#pragma unroll
                for (int kk = 0; kk < 4; ++kk) bn[s2][kk] = *(const bf16x8*)(kp + (size_t)(sn * 4 + kk) * 512); }
            f32x16 acc[4];
#pragma unroll
            for (int s2 = 0; s2 < 4; ++s2) acc[s2] = (f32x16){};
#pragma unroll
            for (int kk = 0; kk < 4; ++kk)
#pragma unroll
                for (int s2 = 0; s2 < 4; ++s2) acc[s2] = __builtin_amdgcn_mfma_f32_32x32x16_bf16(af[kk], bc[s2][kk], acc[s2], 0, 0, 0);
            float scv[4][2];
#pragma unroll
            for (int s2 = 0; s2 < 4; ++s2)
#pragma unroll
                for (int e = 0; e < 2; ++e) { float sc = 0.f;
#pragma unroll
                    for (int j = 0; j < 8; ++j) sc = fmaf(wv[e][j], relu1(acc[s2][8 * e + j]), sc);
                    scv[s2][e] = sc; }
            unsigned pk[2][4];
#pragma unroll
            for (int p = 0; p < 2; ++p) { const unsigned nidx = (unsigned)(8191 - ((g * 4 + 2 * p) * 32 + lane));
#pragma unroll
                for (int e = 0; e < 2; ++e) { const auto rr = __builtin_amdgcn_permlane32_swap(__float_as_uint(scv[2 * p][e]), __float_as_uint(scv[2 * p + 1][e]), false, false);
#pragma unroll
                    for (int u = 0; u < 2; ++u) { const unsigned uu = rr[u]; const unsigned key = uu ^ ((unsigned)((int)uu >> 31) | 0x80000000u);
                        pk[p][2 * u + e] = (key & 0xFFFFE000u) | nidx; } } }
            unsigned cmax = 0u;
#pragma unroll
            for (int p = 0; p < 2; ++p) if ((g * 4 + 2 * p) < nsub) {
#pragma unroll
                for (int q = 0; q < 4; ++q) { const bool hit = pk[p][q] > thr[q];
                    const unsigned long long mk = __builtin_amdgcn_ballot_w64(hit);
                    const unsigned pre = __builtin_amdgcn_mbcnt_hi((unsigned)(mk >> 32), __builtin_amdgcn_mbcnt_lo((unsigned)mk, 0u));
                    CAND[hit ? (unsigned)((4 * wave + q) * ICAP) + cnt[q] + pre : (unsigned)(32 * ICAP + 8192) + (unsigned)tid] = pk[p][q];
                    cnt[q] += (unsigned)__popcll(mk); } }
#pragma unroll
            for (int q = 0; q < 4; ++q) cmax = cnt[q] > cmax ? cnt[q] : cmax;
            if (cmax > (unsigned)(ICAP - 128)) { LDS_WAIT();
#pragma unroll
                for (int q = 0; q < 4; ++q) if (cnt[q] > (unsigned)(ICAP - 128)) { unsigned target = 256u;
                    if (pass == 0 && ((firstmask >> q) & 1u)) { unsigned k0 = (unsigned)(512.0f * (float)cnt[q] / (float)L); k0 = k0 < 32u ? 32u : k0; if (k0 < 256u) { target = k0; guessed |= 1u << q; } }
                    firstmask &= ~(1u << q);
                    const unsigned P = compact_top(CAND + (4 * wave + q) * ICAP, (int)cnt[q], lane, (int)target); cnt[q] = target; thr[q] = P - 1u; }
 }
#pragma unroll
            for (int s2 = 0; s2 < 4; ++s2)
#pragma unroll
                for (int kk = 0; kk < 4; ++kk) bc[s2][kk] = bn[s2][kk];
        }
        bool ok = true;
#pragma unroll
        for (int q = 0; q < 4; ++q) ok = ok && !(((guessed >> q) & 1u) && cnt[q] < 256u);
        if (ok) break;
        LDS_WAIT();
        }
        LDS_WAIT();
        if (unit_of(i + 1) < NB * 128 * 2) request(unit_of(i + 1));
        __syncthreads();
#pragma unroll
        for (int q = 0; q < 4; ++q) { const LAS unsigned* bufq = CAND + (4 * wave + q) * ICAP;
            if (cnt[q] <= 576u) select_bits<9>(bufq, (int)cnt[q], lane, MASK, 1u << (4 * wave + q)); else select_bits<ICJ>(bufq, (int)cnt[q], lane, MASK, 1u << (4 * wave + q)); }
        LDS_WAIT();
        __syncthreads();
        { u32x4* mg = (u32x4*)(maskg + ((size_t)(b * 256 + c * 2 + half) * 128) * 64); const int ntb = 4 * ((c >> 2) + 1);
          for (int j = tid; j < ntb * 16; j += 512) mg[j] = *(const LAS u32x4*)(MASK + j * 4); }
    }
}

__device__ __forceinline__ int wg_ticket(Frame& F, unsigned* ctr) {
    volatile LAS int* w = (volatile LAS int*)(F.lds + LDSCTL_OFF + 256);
    __syncthreads();
    if (F.tid == 0) *w = (int)__hip_atomic_fetch_add(ctr, 1u, __ATOMIC_RELAXED, __HIP_MEMORY_SCOPE_AGENT);
    __syncthreads();
    return *w;
}
__device__ __forceinline__ void ret_scan_phase(Frame& F) {
    bf16_t* KV = (bf16_t*)(F.ws + WS_KV);
    unsigned* qc = (unsigned*)(F.ws + WS_CTL) + CW_Q_SCAN;
    for (int tk = wg_ticket(F, qc); tk < NB * 4 * 8192 / 512; tk = wg_ticket(F, qc)) { const int el = tk * 512 + F.tid;
        const int bh = el >> 13, r = el & 8191, h = bh & 3;
        const float dl = exp2f(64.0f * ret_log2g(h));
        bf16_t* p = KV + (size_t)bh * 128 * 8192 + r; float P = 0.f;
        for (int c = 0; c < 128; c += 16) { bf16_t t[16];
#pragma unroll
            for (int i = 0; i < 16; ++i) t[i] = p[(size_t)(c + i) * 8192];
#pragma unroll
            for (int i = 0; i < 16; ++i) { p[(size_t)(c + i) * 8192] = f2bf(P); P = dl * P + bf2f(t[i]); } }
    }
}
__device__ __forceinline__ void ret_out_phase(Frame& F) {
    const bf16_t* vTb = (const bf16_t*)(F.ws + WS_VTB); const bf16_t* qr = (const bf16_t*)(F.ws + WS_QR); const bf16_t* kr = (const bf16_t*)(F.ws + WS_KR);
    const bf16_t* KV = (const bf16_t*)(F.ws + WS_KV); bf16_t* proj = (bf16_t*)(F.ws + WS_PROJ);
    const int lane = F.lane, l31 = lane & 31, hf = lane >> 5;
    unsigned* qc = (unsigned*)(F.ws + WS_CTL) + CW_Q_ROUT;
    for (int tk = wg_ticket(F, qc); tk < NB * 128 * 4 / 8; tk = wg_ticket(F, qc)) { const int u = tk * 8 + F.wave;
        const int b = u >> 9, c = (u >> 2) & 127, h = u & 3; const int tok0 = b * SEQ + c * 64;
        const float lg = ret_log2g(h);
        const bf16_t* vt = vTb + (size_t)(b * 512 + h * 128) * SEQ + c * 64;
        const bf16_t* st = KV + ((size_t)((b * 4 + h) * 128 + c) * 128) * 64;
        for (int nt = 0; nt < 2; ++nt) {
            const int npos = 32 * nt + l31; const int tok = tok0 + npos;
            bf16x8 qf[4];
#pragma unroll
            for (int kk = 0; kk < 4; ++kk) qf[kk] = *(const bf16x8*)(qr + (size_t)tok * 256 + h * 64 + 16 * kk + 8 * hf);
            f32x16 y[4];
#pragma unroll
            for (int dt = 0; dt < 4; ++dt) { y[dt] = (f32x16){};
#pragma unroll
                for (int kk = 0; kk < 4; ++kk) y[dt] = __builtin_amdgcn_mfma_f32_32x32x16_bf16(*(const bf16x8*)(st + (size_t)(32 * dt + l31) * 64 + 16 * kk + 8 * hf), qf[kk], y[dt], 0, 0, 0); }
            const float xi = exp2f((float)(npos + 1) * lg);
#pragma unroll
            for (int dt = 0; dt < 4; ++dt)
#pragma unroll
                for (int a = 0; a < 16; ++a) y[dt][a] *= xi;
            for (int mt = 0; mt <= nt; ++mt) {
                f32x16 s = {};
#pragma unroll
                for (int kk = 0; kk < 4; ++kk) { const bf16x8 kf = *(const bf16x8*)(kr + (size_t)(tok0 + 32 * mt + l31) * 256 + h * 64 + 16 * kk + 8 * hf); s = __builtin_amdgcn_mfma_f32_32x32x16_bf16(kf, qf[kk], s, 0, 0, 0); }
#pragma unroll
                for (int a = 0; a < 16; ++a) { const int diff = npos - (32 * mt + crow(a, hf)); s[a] = diff >= 0 ? s[a] * exp2f((float)diff * lg) : 0.f; }
                const bf16x8 p0 = pack8(s[0], s[1], s[2], s[3], s[4], s[5], s[6], s[7]), p1 = pack8(s[8], s[9], s[10], s[11], s[12], s[13], s[14], s[15]);
#pragma unroll
                for (int dt = 0; dt < 4; ++dt) { const bf16_t* vrow = vt + (size_t)(32 * dt + l31) * SEQ + 32 * mt + 4 * hf;
                    const u32x2 a0 = *(const u32x2*)(vrow), a1 = *(const u32x2*)(vrow + 8), a2 = *(const u32x2*)(vrow + 16), a3 = *(const u32x2*)(vrow + 24);
                    u32x4 f0; f0.x = a0.x; f0.y = a0.y; f0.z = a1.x; f0.w = a1.y; u32x4 f1; f1.x = a2.x; f1.y = a2.y; f1.z = a3.x; f1.w = a3.y;
                    y[dt] = __builtin_amdgcn_mfma_f32_32x32x16_bf16(__builtin_bit_cast(bf16x8, f0), p0, y[dt], 0, 0, 0);
                    y[dt] = __builtin_amdgcn_mfma_f32_32x32x16_bf16(__builtin_bit_cast(bf16x8, f1), p1, y[dt], 0, 0, 0); }
            }
            float sm = 0.f;
#pragma unroll
            for (int dt = 0; dt < 4; ++dt)
#pragma unroll
                for (int a = 0; a < 16; ++a) sm += y[dt][a];
            sm += __shfl_xor(sm, 32); const float mean = sm * (1.f / 128.f); float sq = 0.f;
#pragma unroll
            for (int dt = 0; dt < 4; ++dt)
#pragma unroll
                for (int a = 0; a < 16; ++a) { const float d = y[dt][a] - mean; sq += d * d; }
            sq += __shfl_xor(sq, 32); const float rstd = rsqrtf(sq * (1.f / 128.f) + 1e-6f);
            LAS unsigned char* yt = F.lds + F.wave * 17408 + npos * 272 + 8 * hf;
#pragma unroll
            for (int dt = 0; dt < 4; ++dt)
#pragma unroll
                for (int i4 = 0; i4 < 4; ++i4) { u32x2 w; w.x = pk2((y[dt][4 * i4] - mean) * rstd, (y[dt][4 * i4 + 1] - mean) * rstd); w.y = pk2((y[dt][4 * i4 + 2] - mean) * rstd, (y[dt][4 * i4 + 3] - mean) * rstd);
                    *(LAS u32x2*)(yt + (32 * dt + 8 * i4) * 2) = w; }
        }
        LDS_WAIT();
        { const int sg = lane & 15, tq = lane >> 4; const f32x4 g0 = *(const f32x4*)(Fgn + h * 128 + 8 * sg), g1 = *(const f32x4*)(Fgn + h * 128 + 8 * sg + 4);
          const float gnv[8] = {g0.x, g0.y, g0.z, g0.w, g1.x, g1.y, g1.z, g1.w};
#pragma unroll 4
          for (int it = 0; it < 16; ++it) { const int tl = it * 4 + tq; bf16_t* prow = proj + (size_t)(tok0 + tl) * NP + h * 128 + 8 * sg;
              const u32x4 gv = *(const u32x4*)(prow + C_GB); const u32x4 yv = *(const LAS u32x4*)(F.lds + F.wave * 17408 + tl * 272 + sg * 16);
              const unsigned gw[4] = {gv.x, gv.y, gv.z, gv.w}, yw[4] = {yv.x, yv.y, yv.z, yv.w}; unsigned ow[4];
#pragma unroll
              for (int e = 0; e < 4; ++e) { const float ga = __uint_as_float(gw[e] << 16), gb = __uint_as_float(gw[e] & 0xffff0000u);
                  const float sa = ga * __builtin_amdgcn_rcpf(1.0f + __builtin_amdgcn_exp2f(-LOG2E * ga)), sb = gb * __builtin_amdgcn_rcpf(1.0f + __builtin_amdgcn_exp2f(-LOG2E * gb));
                  ow[e] = pk2(__uint_as_float(yw[e] << 16) * gnv[2 * e] * sa, __uint_as_float(yw[e] & 0xffff0000u) * gnv[2 * e + 1] * sb); }
              u32x4 o; o.x = ow[0]; o.y = ow[1]; o.z = ow[2]; o.w = ow[3]; *(u32x4*)(prow + C_VB) = o; } }
        LDS_WAIT();
    }
}

namespace attn_body {
using bf16=__hip_bfloat16;
using bf16x8=__attribute__((ext_vector_type(8)))short;
using s16x4=__attribute__((ext_vector_type(4)))short;
using f32x16=__attribute__((ext_vector_type(16)))float;
using u32x4=__attribute__((ext_vector_type(4)))unsigned;
constexpr int BATCH=8,NHEAD=8,SEQ=8192,D=64,DM=3840;
constexpr int NW=8,QBLK=32,QB=QBLK*NW,KVBLK=64,NQB=SEQ/QB;
constexpr int ATTN_PITCH=DM, ATTN_UNIT_ROWS=QB;
__device__ __forceinline__ int crow(int r,int hi){return (r&3)+8*(r>>2)+4*hi;}
#define SBAR() __builtin_amdgcn_sched_barrier(0)
typedef const __attribute__((address_space(4))) unsigned long long* MaskP;
constexpr int BT_OFF=86016, BT_STRIDE=352;
constexpr int NSLOT=3, SLOTB=8192;
constexpr int LDS_K=0, LDS_V=NSLOT*SLOTB, LDS_WS=2*NSLOT*SLOTB, LDS_OST=LDS_WS+NW*64*4, LDS_BYTES=LDS_OST+NW*4096;
constexpr float C2=0.125f*1.4426950408889634f;
__device__ __forceinline__ void glds16(const void*gsrc,unsigned lds_dst){unsigned keep;
  asm volatile("s_mov_b32 %0, m0\n\ts_mov_b32 m0, %2\n\ts_nop 0\n\tglobal_load_lds_dwordx4 %1, off\n\ts_mov_b32 m0, %0":"=&s"(keep):"v"(gsrc),"s"(lds_dst):"memory");}
__device__ __forceinline__ float max3f(float a,float b,float c){float r;asm("v_max3_f32 %0, %1, %2, %3":"=v"(r):"v"(a),"v"(b),"v"(c));return r;}
__device__ __forceinline__ float max2f(float a,float b){float r;asm("v_max_f32_e32 %0, %1, %2":"=v"(r):"v"(a),"v"(b));return r;}
__device__ __forceinline__ float fadd_s(float a,float b){float r;asm("v_add_f32_e32 %0, %1, %2":"=v"(r):"v"(a),"v"(b));return r;}
__device__ __forceinline__ float fsub_s(float a,float b){float r;asm("v_sub_f32_e32 %0, %1, %2":"=v"(r):"v"(a),"v"(b));return r;}
typedef float f32x2_t __attribute__((ext_vector_type(2))); typedef __bf16 bf16x2_t __attribute__((ext_vector_type(2)));
__device__ __forceinline__ unsigned cvtpk_s(float lo,float hi){f32x2_t v={lo,hi};bf16x2_t b=__builtin_convertvector(v,bf16x2_t);return __builtin_bit_cast(unsigned,b);}
#define WAIT_BAR(N) do{ asm volatile("":::"memory"); __builtin_amdgcn_s_waitcnt(0x0070|(N)); __builtin_amdgcn_s_barrier(); asm volatile("":::"memory"); }while(0)

__device__ __forceinline__ void qkt(f32x16&p0,f32x16&p1,const char*Kslot,const bf16x8*qr,const f32x16&negm,int r32,int hi){
  const char*kb=Kslot+hi*1024+r32*16;
  #pragma unroll
  for(int d0=0;d0<4;++d0){
    const bf16x8 b0=*reinterpret_cast<const bf16x8*>(kb+d0*2048);
    const bf16x8 b1=*reinterpret_cast<const bf16x8*>(kb+d0*2048+512);
    if(d0==0){p0=__builtin_amdgcn_mfma_f32_32x32x16_bf16(b0,qr[0],negm,0,0,0);p1=__builtin_amdgcn_mfma_f32_32x32x16_bf16(b1,qr[0],negm,0,0,0);}
    else{p0=__builtin_amdgcn_mfma_f32_32x32x16_bf16(b0,qr[d0],p0,0,0,0);p1=__builtin_amdgcn_mfma_f32_32x32x16_bf16(b1,qr[d0],p1,0,0,0);}}
}
typedef __attribute__((address_space(3))) const char* lds_cptr;
typedef short v4i16_t __attribute__((ext_vector_type(4)));
__device__ __forceinline__ void kload8(bf16x8*kf,lds_cptr kp){
  kf[0]=*(const __attribute__((address_space(3))) bf16x8*)(kp);      kf[1]=*(const __attribute__((address_space(3))) bf16x8*)(kp+512);
  kf[2]=*(const __attribute__((address_space(3))) bf16x8*)(kp+2048); kf[3]=*(const __attribute__((address_space(3))) bf16x8*)(kp+2560);
  kf[4]=*(const __attribute__((address_space(3))) bf16x8*)(kp+4096); kf[5]=*(const __attribute__((address_space(3))) bf16x8*)(kp+4608);
  kf[6]=*(const __attribute__((address_space(3))) bf16x8*)(kp+6144); kf[7]=*(const __attribute__((address_space(3))) bf16x8*)(kp+6656);
}
__device__ __forceinline__ void kload2(bf16x8*kf,lds_cptr kp,int j){ kf[2*j]=*(const __attribute__((address_space(3))) bf16x8*)(kp+j*2048); kf[2*j+1]=*(const __attribute__((address_space(3))) bf16x8*)(kp+j*2048+512); }
__device__ __forceinline__ s16x4 vtr(lds_cptr p){ return __builtin_bit_cast(s16x4,__builtin_amdgcn_ds_read_tr16_b64_v4i16((__attribute__((address_space(3))) v4i16_t*)p)); }
__device__ __forceinline__ float rowmax(const f32x16&p0,const f32x16&p1){
  float a=max3f(p0[0],p0[1],p1[0]),b=max3f(p0[2],p0[3],p1[1]);a=max3f(a,p1[2],p1[3]);
  #pragma unroll
  for(int r=4;r<16;r+=4){a=max3f(a,p0[r],p0[r+1]);b=max3f(b,p0[r+2],p0[r+3]);a=max3f(a,p1[r],p1[r+1]);b=max3f(b,p1[r+2],p1[r+3]);}
  const float m=max2f(a,b);
  auto rr=__builtin_amdgcn_permlane32_swap(__float_as_uint(m),__float_as_uint(m),false,false);
  return max2f(__uint_as_float(rr[0]),__uint_as_float(rr[1]));
}
__device__ __forceinline__ void pv(f32x16*o,int vb,bf16x8 pa0,bf16x8 pa1,bf16x8 pa2,bf16x8 pa3){
  #pragma unroll
  for(int d0=0;d0<2;++d0){s16x4 lo[4],hi[4];
    #pragma unroll
    for(int ks=0;ks<4;++ks){
      asm volatile("ds_read_b64_tr_b16 %0,%1 offset:%c2":"=&v"(lo[ks]):"v"(vb),"i"(d0*4096+ks*1024):"memory");
      asm volatile("ds_read_b64_tr_b16 %0,%1 offset:%c2":"=&v"(hi[ks]):"v"(vb),"i"(d0*4096+ks*1024+512):"memory");}
    asm volatile("s_waitcnt lgkmcnt(0)":::"memory");SBAR();
    #define PK(k) (bf16x8){lo[k][0],lo[k][1],lo[k][2],lo[k][3],hi[k][0],hi[k][1],hi[k][2],hi[k][3]}
    o[d0]=__builtin_amdgcn_mfma_f32_32x32x16_bf16(pa0,PK(0),o[d0],0,0,0);
    o[d0]=__builtin_amdgcn_mfma_f32_32x32x16_bf16(pa1,PK(1),o[d0],0,0,0);
    o[d0]=__builtin_amdgcn_mfma_f32_32x32x16_bf16(pa2,PK(2),o[d0],0,0,0);
    o[d0]=__builtin_amdgcn_mfma_f32_32x32x16_bf16(pa3,PK(3),o[d0],0,0,0);
    #undef PK
  }
}

#ifndef ATTN_STORE16
#define ATTN_STORE16(p,v) (*(u32x4*)(p)=(v))
#endif
template<int THRL> __device__ __forceinline__ void attn_unit(int b,int h,int qb,const bf16*Q,const bf16*__restrict__ K,const bf16*__restrict__ V,bf16*O,MaskP maskA,char*shm){
  const int tid=threadIdx.x,lane=tid&63,r32=lane&31,hi=lane>>5; const int wid=__builtin_amdgcn_readfirstlane(tid>>6);
  const long rowbase=(long)b*SEQ; const int q0=qb*QB;
  const bf16*Qw=Q+(rowbase+q0+wid*QBLK)*DM+h*D;
  const bf16*Kh=K+rowbase*DM+h*D,*Vh=V+rowbase*DM+h*D;
  const unsigned lds0=(unsigned)(uintptr_t)shm;
  float*wsf=(float*)(shm+LDS_WS)+wid*64;
  const bf16*ksrc=Kh+(long)lane*DM+wid*8;
  const bf16*vsrc=Vh+(long)(16*(wid&3)+(lane>>2))*DM+(wid>>2)*32+(lane&3)*8;
  const unsigned kdst=lds0+LDS_K+wid*1024, vdst=lds0+LDS_V+wid*1024;
  #define DMA_K(t,slot) glds16(ksrc+(long)(t)*KVBLK*DM,(unsigned)__builtin_amdgcn_readfirstlane(kdst+(slot)))
  #define DMA_V(t,slot) glds16(vsrc+(long)(t)*KVBLK*DM,(unsigned)__builtin_amdgcn_readfirstlane(vdst+(slot)))
  const int vb0=(int)(lds0+LDS_V)+((lane>>4)&1)*32+(lane&3)*8+(4*hi+((lane&15)>>2))*64;
  const char*Kbase=shm+LDS_K; bf16x8 kf[8];
  const lds_cptr shm3=(lds_cptr)shm; const lds_cptr kp0=shm3+LDS_K+hi*1024+r32*16; const lds_cptr vp0=shm3+LDS_V+((lane>>4)&1)*32+(lane&3)*8+(4*hi+((lane&15)>>2))*64;
  const int NT=(q0+QB)/KVBLK;
  DMA_K(0,0);DMA_V(0,0);DMA_K(1,SLOTB);
  bf16x8 qr[4];
  #pragma unroll
  for(int d0=0;d0<4;++d0)qr[d0]=*reinterpret_cast<const bf16x8*>(&Qw[(long)r32*DM+d0*16+hi*8]);
  float mhat=0.f,l_reg=0.f;f32x16 o[2];o[0]=f32x16{};o[1]=f32x16{};f32x16 negm=f32x16{};asm volatile("":"+v"(negm));
  const int qrel=wid*QBLK+r32;
  const MaskP mrow=maskA+((long)(b*256+(q0>>5)+wid)*128)*32;
  const __attribute__((address_space(3))) float*bt3=(const __attribute__((address_space(3))) float*)((__attribute__((address_space(3))) const char*)shm+BT_OFF)+h*BT_STRIDE;
  unsigned tch0=0u,tch1=0u,tch2=0u,tch3=0u;
  #define MTOUCH(t) do{ asm volatile(""::"s"(tch0),"s"(tch1),"s"(tch2),"s"(tch3)); const MaskP tp_=mrow+(long)((t)+1)*32; \
      asm volatile("s_load_dword %0, %4, 0x0\n\ts_load_dword %1, %4, 0x40\n\ts_load_dword %2, %4, 0x80\n\ts_load_dword %3, %4, 0xc0":"=&s"(tch0),"=&s"(tch1),"=&s"(tch2),"=&s"(tch3):"s"(tp_)); }while(0)
  #define MLOAD(MA,t) unsigned long long MA[16]; { const MaskP mq_=mrow+(long)(t)*32; _Pragma("unroll") for(int r=0;r<16;++r) MA[r]=mq_[r]; }
  #define CMASK(P0,P1,t,MA) do{ const MaskP mp_=mrow+(long)(t)*32; \
    if((t)>=NT-6){ const int ln_=(int)__builtin_amdgcn_mbcnt_hi(~0u,__builtin_amdgcn_mbcnt_lo(~0u,0u)); const int rb_=64*(t)+4*(ln_>>5)-(q0+wid*QBLK+(ln_&31)); \
      _Pragma("unroll") for(int r=0;r<16;++r){ const int rel_=rb_+(r&3)+8*(r>>2); const int i0_=(rel_<-91?-91:rel_)+91, i1_=(rel_+32<-91?-91:rel_+32)+91; P0[r]+=bt3[i0_]; P1[r]+=bt3[i1_]; if((r&3)==3){ asm volatile("s_waitcnt lgkmcnt(0)":"+v"(P0),"+v"(P1)::"memory"); } } } \
    _Pragma("unroll") for(int r=0;r<16;++r) P0[r]=__builtin_amdgcn_inverse_ballot_w64(MA[r])?P0[r]:-INFINITY; \
    _Pragma("unroll") for(int r=0;r<16;++r) P1[r]=__builtin_amdgcn_inverse_ballot_w64(mp_[16+r])?P1[r]:-INFINITY; }while(0)
  bool resc=false;
  #define START(P0,P1) do{ const float rm=rowmax(P0,P1); resc=false; \
    { const float dl=(rm>0.f)?rm:0.f; mhat=fadd_s(mhat,dl); \
      _Pragma("unroll") for(int r=0;r<16;++r){P0[r]=fsub_s(P0[r],dl);P1[r]=fsub_s(P1[r],dl);} \
      _Pragma("unroll") for(int r=0;r<16;++r)negm[r]=-mhat; asm volatile("":"+v"(negm)); } \
    _Pragma("unroll") for(int r=0;r<16;++r)P0[r]=__builtin_amdgcn_exp2f(P0[r]); }while(0)
  #define RESC() do{ if(resc){ asm volatile("s_waitcnt lgkmcnt(0)":::"memory"); \
      _Pragma("unroll") for(int d_=0;d_<2;++d_) _Pragma("unroll") for(int r=0;r<16;++r)o[d_][r]*=wsf[crow(r,hi)]; } }while(0)
  f32x16 pA0,pA1,pB0,pB1;
  int sl_prev=0,sl_cur=0,sl_next=SLOTB;
  #define ROT() do{sl_prev=sl_cur;sl_cur=sl_next;sl_next=(sl_next==(NSLOT-1)*SLOTB)?0:sl_next+SLOTB;}while(0)
  DMA_K(2,2*SLOTB);
  WAIT_BAR(3);
  qkt(pA0,pA1,Kbase,qr,negm,r32,hi);asm volatile("s_nop 15\n\ts_nop 7":"+v"(pA0),"+v"(pA1));{ MLOAD(m0_,0); CMASK(pA0,pA1,0,m0_); }
  START(pA0,pA1);
  _Pragma("unroll") for(int r=0;r<16;++r)pA1[r]=__builtin_amdgcn_exp2f(pA1[r]);
  WAIT_BAR(0);
  DMA_K(3,0);DMA_V(1,SLOTB);
  ROT();
  kload8(kf,kp0+sl_cur);
  WAIT_BAR(2);
  s16x4 vlo[8],vhi[8]; u32x4 pw0,pw1,pw2,pw3;
  #define PKW(P,B) cvtpk_s(P[B],P[B+1])
  #define PAF(k) __builtin_bit_cast(bf16x8,pw##k)
  #define VFR(i) (bf16x8){vlo[i][0],vlo[i][1],vlo[i][2],vlo[i][3],vhi[i][0],vhi[i][1],vhi[i][2],vhi[i][3]}
  #define PIN(x) asm volatile("":"+v"(x))
  #define MX3(a,b,c) __builtin_fmaxf(__builtin_fmaxf((a),(b)),(c))
  #define GAPA(MF,A0,A1,A2,A3,W0,W1,PW) do{ MF; sacc+=A0; sacc+=A1; sacc+=A2; sacc+=A3; PIN(sacc); W0; W1; PIN(PW); SBAR(); }while(0)
  #define EX(v) __builtin_amdgcn_exp2f(v)
  #define GAPB(MF,X,B) do{ MF; X[B]=EX(X[B]); X[B+1]=EX(X[B+1]); X[B+2]=EX(X[B+2]); X[B+3]=EX(X[B+3]); PIN(X); SBAR(); }while(0)
  #define VRD(i) do{ vlo[i]=vtr(vp_+(((i)>>2)*4096+((i)&3)*1024)); vhi[i]=vtr(vp_+(((i)>>2)*4096+((i)&3)*1024+512)); }while(0)
  #define KRD(G,j) do{ if(G){ kload2(kf,kp0+sl_next,j); SBAR(); } }while(0)
  #define STEP(C0,C1,P0,P1,t,GK,GV,GL) do{ SBAR(); MTOUCH(t); MLOAD(mA_,t); SBAR(); \
    const lds_cptr vp_=vp0+sl_prev; \
    VRD(0); SBAR(); float sacc=(P0[0]+P0[1]); \
    GAPA(C0=__builtin_amdgcn_mfma_f32_32x32x16_bf16(kf[0],qr[0],negm,0,0,0), P0[2],P0[3],P0[4],P0[5],     pw0[0]=PKW(P0,0), pw0[1]=PKW(P0,2), pw0); \
    VRD(4); SBAR(); GAPA(C1=__builtin_amdgcn_mfma_f32_32x32x16_bf16(kf[1],qr[0],negm,0,0,0), P0[6],P0[7],P0[8],P0[9],     pw0[2]=PKW(P0,4), pw0[3]=PKW(P0,6), pw0); \
    VRD(1); SBAR(); GAPA(C0=__builtin_amdgcn_mfma_f32_32x32x16_bf16(kf[2],qr[1],C0,0,0,0),   P0[10],P0[11],P0[12],P0[13], pw1[0]=PKW(P0,8), pw1[1]=PKW(P0,10), pw1); \
    VRD(5); SBAR(); GAPA(C1=__builtin_amdgcn_mfma_f32_32x32x16_bf16(kf[3],qr[1],C1,0,0,0),   P0[14],P0[15],P1[0],P1[1],   pw1[2]=PKW(P0,12),pw1[3]=PKW(P0,14), pw1); \
    VRD(2); SBAR(); GAPA(C0=__builtin_amdgcn_mfma_f32_32x32x16_bf16(kf[4],qr[2],C0,0,0,0),   P1[2],P1[3],P1[4],P1[5],     pw2[0]=PKW(P1,0), pw2[1]=PKW(P1,2), pw2); \
    VRD(6); SBAR(); GAPA(C1=__builtin_amdgcn_mfma_f32_32x32x16_bf16(kf[5],qr[2],C1,0,0,0),   P1[6],P1[7],P1[8],P1[9],     pw2[2]=PKW(P1,4), pw2[3]=PKW(P1,6), pw2); \
    VRD(3); SBAR(); GAPA(C0=__builtin_amdgcn_mfma_f32_32x32x16_bf16(kf[6],qr[3],C0,0,0,0),   P1[10],P1[11],P1[12],P1[13], pw3[0]=PKW(P1,8), pw3[1]=PKW(P1,10), pw3); \
    VRD(7); SBAR(); GAPA(C1=__builtin_amdgcn_mfma_f32_32x32x16_bf16(kf[7],qr[3],C1,0,0,0),   P1[14],P1[15],0.f,0.f,       pw3[2]=PKW(P1,12),pw3[3]=PKW(P1,14), pw3); \
    l_reg+=sacc; \
    if(GK){DMA_K((t)+3,sl_cur);} if(GV){DMA_V((t)+1,sl_next);} \
    CMASK(C0,C1,t,mA_); \
    { float a=MX3(C0[0],C0[1],C1[0]),b=MX3(C0[2],C0[3],C1[1]); a=MX3(a,C1[2],C1[3]); \
      _Pragma("unroll") for(int r=4;r<16;r+=4){a=MX3(a,C0[r],C0[r+1]);b=MX3(b,C0[r+2],C0[r+3]);a=MX3(a,C1[r],C1[r+1]);b=MX3(b,C1[r+2],C1[r+3]);} \
      float rm=__builtin_fmaxf(a,b); { auto rr=__builtin_amdgcn_permlane32_swap(__float_as_uint(rm),__float_as_uint(rm),false,false); rm=__builtin_fmaxf(__uint_as_float(rr[0]),__uint_as_float(rr[1])); } \
      resc=false; \
      if(__builtin_expect(__any(rm>(float)THRL),0)){ const float dl=__builtin_fmaxf(rm,0.f); mhat+=dl; \
        _Pragma("unroll") for(int r=0;r<16;++r){C0[r]-=dl;C1[r]-=dl;} \
        _Pragma("unroll") for(int r=0;r<16;++r)negm[r]=-mhat; asm volatile("":"+v"(negm)); \
        const float f=__builtin_amdgcn_exp2f(-dl); l_reg*=f; if(hi==0)wsf[r32]=f; resc=true; } } \
    SBAR(); \
    GAPB(o[0]=__builtin_amdgcn_mfma_f32_32x32x16_bf16(PAF(0),VFR(0),o[0],0,0,0), C0,0); \
    GAPB(o[1]=__builtin_amdgcn_mfma_f32_32x32x16_bf16(PAF(0),VFR(4),o[1],0,0,0), C0,4); \
    KRD(GL,0); GAPB(o[0]=__builtin_amdgcn_mfma_f32_32x32x16_bf16(PAF(1),VFR(1),o[0],0,0,0), C0,8); \
    KRD(GL,1); GAPB(o[1]=__builtin_amdgcn_mfma_f32_32x32x16_bf16(PAF(1),VFR(5),o[1],0,0,0), C0,12); \
    KRD(GL,2); GAPB(o[0]=__builtin_amdgcn_mfma_f32_32x32x16_bf16(PAF(2),VFR(2),o[0],0,0,0), C1,0); \
    KRD(GL,3); GAPB(o[1]=__builtin_amdgcn_mfma_f32_32x32x16_bf16(PAF(2),VFR(6),o[1],0,0,0), C1,4); \
    GAPB(o[0]=__builtin_amdgcn_mfma_f32_32x32x16_bf16(PAF(3),VFR(3),o[0],0,0,0), C1,8); \
    GAPB(o[1]=__builtin_amdgcn_mfma_f32_32x32x16_bf16(PAF(3),VFR(7),o[1],0,0,0), C1,12); \
    }while(0)
  int t=1;
  for(;t+5<NT;t+=2){
    STEP(pB0,pB1,pA0,pA1,t,true,true,true);     WAIT_BAR(2); RESC(); ROT();
    STEP(pA0,pA1,pB0,pB1,t+1,true,true,true);   WAIT_BAR(2); RESC(); ROT();
  }
  #define ENDW(tt) do{ if((tt)+3<NT){WAIT_BAR(2);} else if((tt)+2<NT){WAIT_BAR(1);} else {WAIT_BAR(0);} }while(0)
  for(;t+1<NT;t+=2){
    STEP(pB0,pB1,pA0,pA1,t,(t+3<NT),(t+1<NT),(t+1<NT));       ENDW(t);   RESC(); ROT();
    STEP(pA0,pA1,pB0,pB1,t+1,(t+4<NT),(t+2<NT),(t+2<NT));     ENDW(t+1); RESC(); ROT();
  }
  STEP(pB0,pB1,pA0,pA1,NT-1,false,false,false); asm volatile("s_waitcnt lgkmcnt(0)"::"s"(tch0),"s"(tch1),"s"(tch2),"s"(tch3):"memory"); RESC();
  { float sacc=pB0[0]+pB0[1]; _Pragma("unroll") for(int r=2;r<16;++r)sacc+=pB0[r]; _Pragma("unroll") for(int r=0;r<16;++r)sacc+=pB1[r]; l_reg+=sacc;
    pw0=(u32x4){PKW(pB0,0),PKW(pB0,2),PKW(pB0,4),PKW(pB0,6)};pw1=(u32x4){PKW(pB0,8),PKW(pB0,10),PKW(pB0,12),PKW(pB0,14)};pw2=(u32x4){PKW(pB1,0),PKW(pB1,2),PKW(pB1,4),PKW(pB1,6)};pw3=(u32x4){PKW(pB1,8),PKW(pB1,10),PKW(pB1,12),PKW(pB1,14)};
    SBAR(); pv(o,vb0+sl_cur,PAF(0),PAF(1),PAF(2),PAF(3)); }
  #undef PKW
  #undef PAF
  #undef VFR
  #undef PIN
  #undef MX3
  #undef GAPA
  #undef GAPB
  #undef EX
  #undef VRD
  #undef KRD
  #undef STEP
  #undef ENDW
  {auto rr=__builtin_amdgcn_permlane32_swap(__float_as_uint(l_reg),__float_as_uint(l_reg),false,false);l_reg=__uint_as_float(rr[0])+__uint_as_float(rr[1]);}
  if(hi==0)wsf[32+r32]=l_reg;asm volatile("s_waitcnt lgkmcnt(0)":::"memory");
  float rli[16];
  #pragma unroll
  for(int r=0;r<16;++r)rli[r]=__builtin_amdgcn_rcpf(wsf[32+crow(r,hi)]);
  bf16*Ow=O+(rowbase+q0+wid*QBLK)*DM+h*D;
  { bf16*stg=(bf16*)(shm+LDS_OST)+wid*2048;
    #pragma unroll
    for(int r=0;r<16;++r){const int orow=crow(r,hi);
      #pragma unroll
      for(int d0=0;d0<2;++d0)stg[orow*64+d0*32+r32]=__float2bfloat16(o[d0][r]*rli[r]);}
    asm volatile("s_waitcnt lgkmcnt(0)":::"memory");
    #pragma unroll
    for(int i=0;i<4;++i){const int row=i*8+(lane>>3),ch=lane&7; const u32x4 v=*(const u32x4*)(stg+row*64+ch*8); ATTN_STORE16(Ow+(long)row*DM+ch*8,v);} }
  asm volatile("s_waitcnt lgkmcnt(0)\n\ts_barrier":::"memory");
  #undef DMA_K
  #undef DMA_V
  #undef CMASK
  #undef MTOUCH
  #undef MLOAD
  #undef START
  #undef RESC
  #undef ROT
}
constexpr int ATTN_LDS_BYTES=LDS_BYTES;
struct AttnTensors { const bf16* Q; const bf16* K; const bf16* V; bf16* O; MaskP mask; };
__device__ __forceinline__ void attn_phase(char*lds,const AttnTensors&T,int grid,int block){
  const int vcu=(grid%8==0)?(block%8)*(grid/8)+block/8:block;
  if(__builtin_amdgcn_readfirstlane(threadIdx.x>>6)>=4) __builtin_amdgcn_s_setprio(1);
  for(int vc=vcu;vc<256;vc+=grid){ const int s=vc&7;
    for(int i=0;i<8;++i){ const int bh=(vc>>3)+32*(i>>2), j=i&3; const int qb=(j==0)?s:(j==1)?15-s:(j==2)?16+s:31-s;
      attn_unit<8>(bh/NHEAD,bh%NHEAD,qb,T.Q,T.K,T.V,T.O,T.mask,lds); } }
  __builtin_amdgcn_s_setprio(0);
}
#undef SBAR
#undef WAIT_BAR
}
__device__ __forceinline__ void attn_phase(Frame& F) {
    LAS float* btab = (LAS float*)(F.lds + attn_body::BT_OFF);
    const float* rbp = Frel_bias;
    for (int i = F.tid; i < 8 * attn_body::BT_STRIDE; i += 512) { const int h = i / attn_body::BT_STRIDE, rel = (i % attn_body::BT_STRIDE) - 91; const int n = rel < 0 ? -rel : rel;
        int bk = n < 8 ? n : (n < 12 ? 8 : n < 16 ? 9 : n < 23 ? 10 : n < 32 ? 11 : n < 46 ? 12 : n < 64 ? 13 : n < 91 ? 14 : 15);
        if (rel > 0) bk += 16;
        btab[i] = (rbp[bk * 8 + h] - rbp[15 * 8 + h]) * LOG2E; }
    __syncthreads();
    attn_body::bf16* proj = (attn_body::bf16*)(F.ws + WS_PROJ);
    const attn_body::AttnTensors T{proj + C_QA, proj + C_KA, proj + C_VA, proj + C_QA, (attn_body::MaskP)(F.ws + WS_MASK)};
    extern __shared__ __attribute__((aligned(16))) unsigned char dyn_lds[];
    attn_body::attn_phase((char*)dyn_lds, T, F.G, (int)blockIdx.x);
}

__device__ __forceinline__ void router_phase(Frame& F) {
    LAS unsigned* lcnt = (LAS unsigned*)F.lds;
    const bf16x8* WRH = (const bf16x8*)(F.ws + WS_WRH); const bf16x8* WRL = (const bf16x8*)(F.ws + WS_WRL);
    unsigned char* H2 = (unsigned char*)(F.ws + WS_H2); unsigned* info = (unsigned*)(F.ws + WS_INFO); float* gate = (float*)(F.ws + WS_GATE); unsigned* wgcnt = (unsigned*)(F.ws + WS_WGCNT);
    const int lane = F.lane, l31 = lane & 31, hf = lane >> 5;
    for (int blk = blockIdx.x; blk < 256; blk += F.G) {
        __syncthreads();
        if (F.tid < 32) lcnt[F.tid] = 0u;
        __syncthreads();
        const int tok = blk * 256 + F.wave * 32 + l31;
        const float* xrow = F.out + (size_t)tok * DM + 8 * hf;
        unsigned char* hrow = H2 + (size_t)tok * DM + 8 * hf; const float* g2p = Fg2 + 8 * hf;
        f32x16 acc = {}; float ssq = 0.f;
        for (int k0 = 0; k0 < 64; k0 += 4) {
            f32x4 av[4], bv4[4], gav[4], gbv[4]; bf16x8 whv[4], wlv[4];
#pragma unroll
            for (int t = 0; t < 4; ++t) { const int kk = k0 + t; av[t] = *(const f32x4*)(xrow + 16 * kk); bv4[t] = *(const f32x4*)(xrow + 16 * kk + 4);
                gav[t] = *(const f32x4*)(g2p + 16 * kk); gbv[t] = *(const f32x4*)(g2p + 16 * kk + 4); whv[t] = WRH[kk * 64 + lane]; wlv[t] = WRL[kk * 64 + lane]; }
            asm volatile("" ::: "memory");
#pragma unroll
            for (int t = 0; t < 4; ++t) { const int kk = k0 + t; const f32x4 a = av[t], bq = bv4[t], ga = gav[t], gb = gbv[t];
                { u32x2 w8; w8.x = pk4_fp8(a.x * ga.x, a.y * ga.y, a.z * ga.z, a.w * ga.w); w8.y = pk4_fp8(bq.x * gb.x, bq.y * gb.y, bq.z * gb.z, bq.w * gb.w); *(u32x2*)(hrow + 16 * kk) = w8; }
                ssq += (a.x * a.x + a.y * a.y) + (a.z * a.z + a.w * a.w) + (bq.x * bq.x + bq.y * bq.y) + (bq.z * bq.z + bq.w * bq.w);
                u32x4 hw; hw.x = pk2(a.x, a.y); hw.y = pk2(a.z, a.w); hw.z = pk2(bq.x, bq.y); hw.w = pk2(bq.z, bq.w);
                u32x4 lw; lw.x = pk2(a.x - __uint_as_float(hw.x << 16), a.y - __uint_as_float(hw.x & 0xffff0000u)); lw.y = pk2(a.z - __uint_as_float(hw.y << 16), a.w - __uint_as_float(hw.y & 0xffff0000u));
                lw.z = pk2(bq.x - __uint_as_float(hw.z << 16), bq.y - __uint_as_float(hw.z & 0xffff0000u)); lw.w = pk2(bq.z - __uint_as_float(hw.w << 16), bq.w - __uint_as_float(hw.w & 0xffff0000u));
                const bf16x8 xh = __builtin_bit_cast(bf16x8, hw), xl = __builtin_bit_cast(bf16x8, lw);
                acc = __builtin_amdgcn_mfma_f32_32x32x16_bf16(whv[t], xh, acc, 0, 0, 0);
                acc = __builtin_amdgcn_mfma_f32_32x32x16_bf16(whv[t], xl, acc, 0, 0, 0);
                acc = __builtin_amdgcn_mfma_f32_32x32x16_bf16(wlv[t], xh, acc, 0, 0, 0); }
        }
        ssq += __shfl_xor(ssq, 32);
        const float rstd = rsqrtf(ssq * (1.f / DM) + 1e-5f);
        float lg[16];
#pragma unroll
        for (int a = 0; a < 16; ++a) lg[a] = acc[a] * rstd + Fb_router[crow(a, hf)];
        float tv[4]; int te[4];
#pragma unroll
        for (int k = 0; k < 4; ++k) { float bv = -3.0e38f; int be = 0;
#pragma unroll
            for (int a = 0; a < 16; ++a) { const bool gt = lg[a] > bv; bv = gt ? lg[a] : bv; be = gt ? crow(a, hf) : be; }
#pragma unroll
            for (int a = 0; a < 16; ++a) lg[a] = (crow(a, hf) == be) ? -3.0e38f : lg[a];
            tv[k] = bv; te[k] = be; }
        float ov[4]; int oe[4];
#pragma unroll
        for (int k = 0; k < 4; ++k) { ov[k] = __shfl_xor(tv[k], 32); oe[k] = __shfl_xor(te[k], 32); }
        float mv[4]; int me[4]; { int ia = 0, ib = 0;
#pragma unroll
            for (int k = 0; k < 4; ++k) { float va = tv[0], vb = ov[0]; int ea = te[0], eb = oe[0];
#pragma unroll
                for (int j = 1; j < 4; ++j) { va = (ia == j) ? tv[j] : va; ea = (ia == j) ? te[j] : ea; vb = (ib == j) ? ov[j] : vb; eb = (ib == j) ? oe[j] : eb; }
                const bool ta = (va > vb) || (va == vb && ea < eb); mv[k] = ta ? va : vb; me[k] = ta ? ea : eb; ia += ta ? 1 : 0; ib += ta ? 0 : 1; } }
        float ge[4]; float gs = 0.f;
#pragma unroll
        for (int k = 0; k < 4; ++k) { ge[k] = __builtin_amdgcn_exp2f((mv[k] - mv[0]) * LOG2E); gs += ge[k]; }
        const float gi = 1.0f / gs;
        if (hf == 0) {
#pragma unroll
            for (int k = 0; k < 4; ++k) { const unsigned lr = __hip_atomic_fetch_add(lcnt + me[k], 1u, __ATOMIC_RELAXED, __HIP_MEMORY_SCOPE_WORKGROUP);
                info[(size_t)tok * 4 + k] = ((unsigned)me[k] << 20) | lr; gate[(size_t)tok * 4 + k] = ge[k] * gi; } }
        if (hf == 0) ((float*)(F.ws + WS_RSTD))[tok] = rstd;
        LDS_WAIT();
        __syncthreads();
        if (F.tid < 32) wgcnt[blk * 32 + F.tid] = lcnt[F.tid];
    }
}
__device__ __forceinline__ void rows_phase(Frame& F) {
    LAS int* tot = (LAS int*)F.lds; LAS int* pre = tot + 32; LAS int* base = tot + 64;
    const unsigned* wgcnt = (const unsigned*)(F.ws + WS_WGCNT); const unsigned* info = (const unsigned*)(F.ws + WS_INFO); const float* gate = (const float*)(F.ws + WS_GATE);
    int* tokrow = (int*)(F.ws + WS_TOKROW); float* grow = (float*)(F.ws + WS_GROW); int* gbase = (int*)(F.ws + WS_BASE);
    for (int blk = blockIdx.x; blk < 256; blk += F.G) {
        __syncthreads();
        if (F.tid < 32) { int t = 0, p = 0; for (int j = 0; j < 256; ++j) { const int v = (int)wgcnt[j * 32 + F.tid]; p = (j == blk) ? t : p; t += v; } tot[F.tid] = t; pre[F.tid] = p; }
        __syncthreads();
        if (F.tid == 0) { int s = 0; for (int e = 0; e < 32; ++e) { base[e] = s; s += (tot[e] + 255) & ~255; } base[32] = s; }
        __syncthreads();
        if (blk == 0 && F.tid < 33) gbase[F.tid] = base[F.tid];
        if (blk == 0) { int* mte = (int*)(F.ws + WS_MTE); for (int mt = F.tid; mt < base[32] / 256; mt += 512) { int e = 0; for (int j = 1; j < NEXP; ++j) e = (base[j] <= mt * 256) ? j : e; mte[mt] = e; } }
        for (int i = F.tid; i < 1024; i += 512) { const int tok = blk * 256 + (i >> 2); const unsigned v = info[(size_t)blk * 1024 + i]; const int e = (int)(v >> 20), lr = (int)(v & 0xFFFFFu);
            const int row = base[e] + pre[e] + lr; tokrow[row] = tok * 4 + (i & 3); grow[row] = gate[(size_t)blk * 1024 + i]; ((float*)(F.ws + WS_RROW))[row] = ((const float*)(F.ws + WS_RSTD))[tok]; }
        if (blk < 32) { const int e = blk; for (int rr = base[e] + tot[e] + F.tid; rr < base[e + 1]; rr += 512) { tokrow[rr] = -1; grow[rr] = 0.f; ((float*)(F.ws + WS_RROW))[rr] = 0.f; } }
    }
    __syncthreads();
    LAS float* scr = (LAS float*)(F.lds + 1024 + F.wave * 16384);
    unsigned char* W1T = (unsigned char*)(F.ws + WS_W1T); unsigned char* W2T = (unsigned char*)(F.ws + WS_W2T);
    constexpr int I1 = 16 * 32, I2 = 16 * 16;
    for (int it = blockIdx.x * 8 + F.wave; it < NEXP * (I1 + I2); it += F.G * 8) {
        if (it < NEXP * I1) { const int e = it / I1, r = it % I1, kb = r / 32, nb = r % 32;
            tr_item_f8x2(Fw1 + (size_t)e * DM * 2048, 2048, DM, W1T + (size_t)e * 2048 * DM, scr, kb * 64, nb * 64, F.lane, 32.0f); }
        else { const int q = it - NEXP * I1; const int e = q / I2, r = q % I2, kb = r / 16, nb = r % 16;
            tr_item_f8x2(Fw2 + (size_t)e * DFF * DM, DM, DFF, W2T + (size_t)e * DM * DFF, scr, kb * 64, nb * 64, F.lane, 32.0f); }
    }
}
__device__ __forceinline__ void final_phase(Frame& F) {
    const int NGW = F.G * 8; const f32x4* gr = (const f32x4*)Fgf + F.lane;
    for (int m0 = blockIdx.x * 8 + F.wave; m0 < MTOK; m0 += 2 * NGW) {
        f32x4 v[2][4]; unsigned w[2][4][4]; int mr[2];
#pragma unroll
        for (int t = 0; t < 2; ++t) { const int m = m0 + t * NGW; mr[t] = m < MTOK ? m : m0;
            const f32x4* xr = (const f32x4*)(F.out + (size_t)mr[t] * DM) + F.lane; const unsigned* yr = (const unsigned*)((const unsigned char*)(F.ws + WS_Y) + (size_t)mr[t] * 4 * DM) + F.lane;
#pragma unroll
            for (int j = 0; j < 4; ++j) { v[t][j] = xr[64 * j];
#pragma unroll
                for (int k = 0; k < 4; ++k) w[t][k][j] = yr[k * 256 + 64 * j]; } }
#pragma unroll
        for (int t = 0; t < 2; ++t) { float s = 0.f;
#pragma unroll
            for (int j = 0; j < 4; ++j) {
#pragma unroll
                for (int k = 0; k < 4; ++k) { const unsigned q = w[t][k][j]; typedef float f2 __attribute__((ext_vector_type(2)));
                    const f2 lo = __builtin_amdgcn_cvt_pk_f32_fp8((int)q, false), hi = __builtin_amdgcn_cvt_pk_f32_fp8((int)q, true);
                    v[t][j].x += lo.x * 0.0625f; v[t][j].y += lo.y * 0.0625f; v[t][j].z += hi.x * 0.0625f; v[t][j].w += hi.y * 0.0625f; }
                s += (v[t][j].x * v[t][j].x + v[t][j].y * v[t][j].y) + (v[t][j].z * v[t][j].z + v[t][j].w * v[t][j].w); }
            const float r = rsqrtf(wave_sum(s) * (1.f / DM) + 1e-5f);
            if (t == 0 || m0 + NGW < MTOK) { f32x4* xo = (f32x4*)(F.out + (size_t)mr[t] * DM) + F.lane;
#pragma unroll
                for (int j = 0; j < 4; ++j) { const f32x4 g = gr[64 * j]; xo[64 * j] = v[t][j] * r * g; } } }
    }
}

constexpr int N_PHASES = 11;
__global__ void __launch_bounds__(512, 2) mk_fwd(Args args) {
    extern __shared__ __attribute__((aligned(16))) unsigned char lds[];
    Frame F;
    F.lds = (LAS unsigned char*)lds;
    F.tid = threadIdx.x; F.lane = F.tid & 63; F.wave = __builtin_amdgcn_readfirstlane(F.tid >> 6); F.G = gridDim.x;
    F.ws = args.ws; F.out = args.out;
    F.ap = (const __attribute__((address_space(4))) Args*)__builtin_amdgcn_kernarg_segment_ptr();
    volatile LAS unsigned* MISC = (volatile LAS unsigned*)(F.lds + LDSCTL_OFF);
    for (int u = F.tid; u < (LDS_BYTES - LDSCTL_OFF) / 4; u += 512) ((LAS unsigned*)(F.lds + LDSCTL_OFF))[u] = 0u;
    __syncthreads();
    unsigned* barw = (unsigned*)(F.ws + WS_CTL) + CW_BAR;
    XcdBarrier bar; bar.bar = barw; bar.x = 0; bar.st = nullptr;
    const int lo = args.ph_lo, hi = args.ph_hi;
    const bool multi = (hi - lo) > 1;
    if (multi) bar = xcd_barrier_post(barw, MISC + 8);
#ifdef ONLYP
#define IN(k) ((k) == ONLYP && lo <= (k) && (k) < hi)
#else
#define IN(k) (lo <= (k) && (k) < hi)
#endif
#define SEAM(k) do { if (IN(k) && IN((k) + 1)) xcd_barrier(bar); asm volatile("" : "+s"(F.ap)); } while (0)

    if (IN(0)) { p0_prologue(F); } SEAM(0);
    if (IN(1)) { pg8::DenseOrder<NP / 256> S; S.init(DM, F.ws + WS_WIN, F.G, (int)blockIdx.x); pg8::EpiProj E{(bf16_t*)(F.ws + WS_PROJ)};
        pg8::gemm_phase(F.lds, (const char*)(F.ws + WS_H), DM * 2, DM, S, E); } SEAM(1);
    if (IN(2)) { prep_phase(F); } SEAM(2);
    if (IN(3)) { index_phase(F); ret_scan_phase(F); } SEAM(3);
    if (IN(4)) { attn_phase(F); ret_out_phase(F); } SEAM(4);
    if (IN(5)) { pg8::DenseOrder<DM / 256> S; S.init(DM, F.ws + WS_WOUT, F.G, (int)blockIdx.x); pg8::EpiRes E{Fx, F.out};
        pg8::gemm_phase(F.lds, (const char*)(F.ws + WS_PROJ), NP * 2, DM, S, E); } SEAM(5);
    if (IN(6)) { router_phase(F); } SEAM(6);
    if (IN(7)) { rows_phase(F); } SEAM(7);
#define MOE_G1(ph, LO, CNT) if (IN(ph)) { const int* gbase = (const int*)(F.ws + WS_BASE); const int nall = gbase[32] / 256; \
        pg8::MoeOrder<8, true> S; S.G = F.G; S.c = (int)blockIdx.x; S.K = DM; S.mt_lo = (LO); S.nmt = (CNT); S.mte = (const int*)(F.ws + WS_MTE); S.tokrow = (const int*)(F.ws + WS_TOKROW); S.Wt = (const char*)(F.ws + WS_W1T); S.estride = (size_t)2048 * DM; S.esz = 1; \
        pg8::EpiSwiglu E{Fb1, (unsigned char*)(F.ws + WS_ACT), (LO), (const float*)(F.ws + WS_RROW)}; \
        pg8::gemm_phase<pg8::EpiSwiglu, pg8::MoeOrder<8, true>, 1>(F.lds, (const char*)(F.ws + WS_H2), DM, DM, S, E); } SEAM(ph);
#define MOE_G2(ph, LO, CNT) if (IN(ph)) { const int* gbase = (const int*)(F.ws + WS_BASE); const int nall = gbase[32] / 256; \
        pg8::MoeOrder<4, false> S; S.G = F.G; S.c = (int)blockIdx.x; S.K = DFF; S.mt_lo = (LO); S.nmt = (CNT); S.mte = (const int*)(F.ws + WS_MTE); S.tokrow = (const int*)(F.ws + WS_TOKROW); S.Wt = (const char*)(F.ws + WS_W2T); S.estride = (size_t)DM * DFF; S.esz = 1; \
        pg8::EpiMoeOut E{Fb2, (const int*)(F.ws + WS_TOKROW), (const float*)(F.ws + WS_GROW), (unsigned char*)(F.ws + WS_Y)}; \
        pg8::gemm_phase<pg8::EpiMoeOut, pg8::MoeOrder<4, false>, 1>(F.lds, (const char*)(F.ws + WS_ACT), DFF, DFF, S, E); } SEAM(ph);
    MOE_G1(8, 0, nall)
    MOE_G2(9, 0, nall)
    if (IN(10)) { final_phase(F); }
#undef IN
#undef SEAM
}

extern "C" void kernel_launch(void* const* d_in, const int* in_sizes, int n_in, void* d_out, int out_size, void* d_ws, size_t ws_size, hipStream_t stream) {
    static int grid = 0;
    if (grid == 0) {
        if (n_in != 16 || out_size != MTOK * DM || ws_size < WS_END) { fprintf(stderr, "kernel_launch: unexpected shapes: n_in %d out %d ws %zu (need %zu)\n", n_in, out_size, ws_size, (size_t)WS_END); grid = -1; return; }
        int dev = 0, cus = 0, per_cu = 0;
        if (hipGetDevice(&dev) != hipSuccess || hipDeviceGetAttribute(&cus, hipDeviceAttributeMultiprocessorCount, dev) != hipSuccess) { grid = -1; return; }
        if (hipFuncSetAttribute((const void*)mk_fwd, hipFuncAttributeMaxDynamicSharedMemorySize, LDS_BYTES) != hipSuccess) { fprintf(stderr, "kernel_launch: hipFuncSetAttribute failed\n"); grid = -1; return; }
        if (hipOccupancyMaxActiveBlocksPerMultiprocessor(&per_cu, (const void*)mk_fwd, 512, LDS_BYTES) != hipSuccess || per_cu < 1) fprintf(stderr, "kernel_launch: occupancy query says %d\n", per_cu);
        (void)hipGetLastError();
        grid = cus;
    }
    if (grid < 0) return;
    (void)hipMemsetAsync((char*)d_ws + WS_CTL, 0, CTL_ZERO_BYTES, stream);
    Args a{};
    for (int i = 0; i < 16; ++i) a.in[i] = (const float*)d_in[i];
    a.out = (float*)d_out; a.ws = (unsigned char*)d_ws;
#if MK_ONE_LAUNCH
    a.ph_lo = 0; a.ph_hi = N_PHASES;
    hipLaunchKernelGGL(mk_fwd, dim3(grid), dim3(512), LDS_BYTES, stream, a);
#else
    for (int p = 0; p < N_PHASES; ++p) { a.ph_lo = p; a.ph_hi = p + 1; hipLaunchKernelGGL(mk_fwd, dim3(grid), dim3(512), LDS_BYTES, stream, a); }
#endif
}
```

```cpp
#include <hip/hip_runtime.h>
#include <hip/hip_bf16.h>
#include <cmath>
#include <stdint.h>
#include <stdio.h>

#ifndef MK_ONE_LAUNCH
#define MK_ONE_LAUNCH 1
#endif

#define GAS __attribute__((address_space(1)))
#define LAS __attribute__((address_space(3)))
typedef unsigned short bf16_t;
typedef short bf16x8 __attribute__((ext_vector_type(8)));
typedef float f32x4 __attribute__((ext_vector_type(4)));
typedef float f32x2 __attribute__((ext_vector_type(2)));
typedef float f32x16 __attribute__((ext_vector_type(16)));
typedef unsigned u32x4 __attribute__((ext_vector_type(4)));
typedef unsigned u32x2 __attribute__((ext_vector_type(2)));
typedef __bf16 bf16x2_t __attribute__((ext_vector_type(2)));

constexpr int NB = 8, SEQ = 8192, DM = 1024, MTOK = NB * SEQ;
constexpr int NP = 3840;
constexpr int C_QA = 0, C_VB = 512, C_KA = 1024, C_VA = 1536, C_QI = 2048, C_QB = 2560, C_KB = 2816, C_GB = 3072, C_KI = 3584, C_WI = 3648;
constexpr int NEXP = 32, DFF = 1024;
constexpr float LOG2E = 1.4426950408889634f;
constexpr float QA_SCALE = 0.125f * LOG2E;
constexpr float IDX_W_SCALE = 0.04419417382415922f;
constexpr int MAXROWS = MTOK * 4 + NEXP * 256;

constexpr size_t MiB = 1u << 20;
constexpr size_t WS_CTL = 0, CTL_ZERO_BYTES = 1 * MiB;
constexpr size_t WS_WIN = 1 * MiB;
constexpr size_t WS_WOUT = 9 * MiB;
constexpr size_t WS_INFO = 11 * MiB;
constexpr size_t WS_GATE = 12 * MiB;
constexpr size_t WS_TOKROW = 13 * MiB;
constexpr size_t WS_GROW = 14 * MiB + 256 * 1024;
constexpr size_t WS_WGCNT = 15 * MiB + 512 * 1024;
constexpr size_t WS_BASE = WS_WGCNT + 64 * 1024;
constexpr size_t WS_MTE = WS_BASE + 1024;
constexpr size_t WS_WRH = 15 * MiB + 640 * 1024;
constexpr size_t WS_WRL = WS_WRH + 64 * 1024;
constexpr size_t WS_RSTD = 15 * MiB + 768 * 1024;
constexpr size_t WS_RROW = 1000 * MiB;
constexpr size_t WS_W1T = 16 * MiB;
constexpr size_t WS_W2T = 80 * MiB;
constexpr size_t WS_KV = 16 * MiB;
constexpr size_t WS_MASK = 144 * MiB;
constexpr size_t WS_PROJ = 208 * MiB;
constexpr size_t WS_ACT = 208 * MiB;
constexpr size_t WS_Y = 472 * MiB;
constexpr size_t WS_H = 688 * MiB;
constexpr size_t WS_VTB = 688 * MiB;
constexpr size_t WS_QR = 752 * MiB;
constexpr size_t WS_KR = 784 * MiB;
constexpr size_t WS_VTA = 816 * MiB;
constexpr size_t WS_KTZ = 880 * MiB;
constexpr size_t WS_KILN = 912 * MiB;
constexpr size_t WS_WBUF = 920 * MiB;
constexpr size_t WS_H2 = 112 * MiB;
constexpr size_t WS_END = 1024 * MiB;
static_assert(WS_W1T + (size_t)NEXP * 2048 * 1024 <= WS_W2T && WS_W2T + (size_t)NEXP * 1024 * 1024 <= WS_H2 && WS_H2 + (size_t)MTOK * 1024 <= WS_ACT && WS_ACT + (size_t)(MAXROWS) * 1024 <= WS_Y && WS_Y + (size_t)MTOK * 4 * 1024 * 2 <= WS_END, "MoE buffers fit");

constexpr int CW_BAR = 4096;
constexpr int CW_Q_SCAN = 8192, CW_Q_ROUT = 8256;

constexpr int LDS_SCRATCH = 151552;
constexpr int LDSCTL_OFF = LDS_SCRATCH;
constexpr int LDS_BYTES = 155648;

__device__ __forceinline__ float bf2f(bf16_t b) { return __uint_as_float(((unsigned)b) << 16); }
__device__ __forceinline__ unsigned pk2(float lo, float hi) { f32x2 v = {lo, hi}; bf16x2_t b = __builtin_convertvector(v, bf16x2_t); return __builtin_bit_cast(unsigned, b); }
__device__ __forceinline__ bf16_t f2bf(float f) { return (bf16_t)(pk2(f, 0.f) & 0xffffu); }
__device__ __forceinline__ float wave_sum(float v) {
#pragma unroll
    for (int o = 1; o < 64; o <<= 1) v += __shfl_xor(v, o);
    return v;
}
__device__ __forceinline__ int crow(int r, int hi) { return (r & 3) + 8 * (r >> 2) + 4 * hi; }
__device__ __forceinline__ bf16x8 pack8(float a0, float a1, float a2, float a3, float a4, float a5, float a6, float a7) {
    u32x4 w; w.x = pk2(a0, a1); w.y = pk2(a2, a3); w.z = pk2(a4, a5); w.w = pk2(a6, a7); return __builtin_bit_cast(bf16x8, w);
}
__device__ __forceinline__ unsigned pk4_fp8(float a, float b, float c, float d) {
    a = fminf(fmaxf(a, -448.f), 448.f); b = fminf(fmaxf(b, -448.f), 448.f); c = fminf(fmaxf(c, -448.f), 448.f); d = fminf(fmaxf(d, -448.f), 448.f);
    int w = __builtin_amdgcn_cvt_pk_fp8_f32(a, b, 0, false); w = __builtin_amdgcn_cvt_pk_fp8_f32(c, d, w, true); return (unsigned)w; }
__device__ __forceinline__ unsigned pk4_fp8_nc(float a, float b, float c, float d) {
    int w = __builtin_amdgcn_cvt_pk_fp8_f32(a, b, 0, false); w = __builtin_amdgcn_cvt_pk_fp8_f32(c, d, w, true); return (unsigned)w; }
#define LDS_WAIT() asm volatile("s_waitcnt lgkmcnt(0)" ::: "memory")
#define VM_WAIT() asm volatile("s_waitcnt vmcnt(0)" ::: "memory")

namespace pg8 {
constexpr int BM = 256, BK = 64, HALF = 128, HTB = HALF * BK * 2, STAGE_BYTES = 8 * HTB, NXCD = 8, WGM = 4;
constexpr int ROWT_OFF = STAGE_BYTES, MTE_OFF = STAGE_BYTES + 2048;
constexpr int UNITT_OFF = MTE_OFF + 4352 + 3 * 3072, UNITT_N = 64;
constexpr int EPIT_OFF = MTE_OFF + 4352, EPIT_SLOT = 3072;
__host__ __device__ __forceinline__ int lds_byte(int r, int c) { const int st = (r >> 4) * 2 + (c >> 5), rr = r & 15, cc = c & 31, ob = rr * 64 + cc * 2; return st * 1024 + (ob ^ (((ob >> 9) & 1) << 5)); }
__host__ __device__ __forceinline__ void stage_rc(int b, int& R, int& C) { const int st = b / 1024, sb = b % 1024, swz = sb ^ (((sb >> 9) & 1) << 5); R = (st >> 1) * 16 + swz / 64; C = (st & 1) * 32 + (swz % 64) / 2; }
__host__ __device__ __forceinline__ int perm32(int rho) { const int n = rho >> 4, i = rho & 15; return 8 * (i >> 2) + 4 * n + (i & 3); }

struct Unit { int pm, pn, e; const char* B; };

typedef int v8i32 __attribute__((ext_vector_type(8)));
template <class Epi, class Sched, int MODE = 0>
__device__ __forceinline__ void gemm_phase(LAS unsigned char* lds, const char* Ab, unsigned lda2, int K, Sched& S, const Epi& E) {
    const int tid = threadIdx.x, wid = __builtin_amdgcn_readfirstlane(tid >> 6), lane = tid & 63, wr = wid >> 2, wc = wid & 3, fr = lane & 15, fq = lane >> 4;
    const int rowB = MODE ? K : 2 * K;
    const int nt = rowB / 128;
    int Rp[2]; unsigned Cp2[2], voffB[2];
#pragma unroll
    for (int i = 0; i < 2; ++i) { int R, C; stage_rc(tid * 16 + i * 8192, R, C); const int Rb = Epi::PERM ? ((R & ~31) + perm32(R & 31)) : R;
        Rp[i] = R; Cp2[i] = (unsigned)C * 2u; voffB[i] = (unsigned)(Rb * rowB + C * 2); }
    const size_t hstepB = (size_t)HALF * rowB;
    const unsigned ldsw = (unsigned)wid * 1024u;
    const int aoff = lds_byte(wr * 64 + fr, fq * 8), boff = lds_byte(wc * 32 + fr, fq * 8);
#define PG8_SA(b, h) (((b) * 2 + (h)) * HTB)
#define PG8_SB(b, h) ((4 + (b) * 2 + (h)) * HTB)
#define PG8_STAGE_B(bufoff, gbase) do { _Pragma("unroll") for (int _i = 0; _i < 2; ++_i) \
        __builtin_amdgcn_global_load_lds((const unsigned*)((const char*)(gbase) + voffB[_i]), (LAS unsigned*)(lds + (bufoff) + ldsw + _i * 8192), 16, 0, 0); } while (0)
#define PG8_STAGE_A(bufoff, o0, o1, kb) do { \
        __builtin_amdgcn_global_load_lds((const unsigned*)(Ab + (size_t)(o0) + (size_t)(kb)), (LAS unsigned*)(lds + (bufoff) + ldsw), 16, 0, 0); \
        __builtin_amdgcn_global_load_lds((const unsigned*)(Ab + (size_t)(o1) + (size_t)(kb)), (LAS unsigned*)(lds + (bufoff) + ldsw + 8192), 16, 0, 0); } while (0)
#define PG8_LD8(p) ({ const u32x4 lo_ = *(const LAS u32x4*)(p); const u32x4 hi_ = *(const LAS u32x4*)((p) + 1024); (v8i32){(int)lo_.x, (int)lo_.y, (int)lo_.z, (int)lo_.w, (int)hi_.x, (int)hi_.y, (int)hi_.z, (int)hi_.w}; })
#define PG8_LDA(dst, b, h) do { if constexpr (MODE == 0) { _Pragma("unroll") for (int m = 0; m < 4; ++m) _Pragma("unroll") for (int k = 0; k < 2; ++k) dst[m][k] = *(const LAS bf16x8*)(lds + PG8_SA(b, h) + aoff + m * 2048 + k * 1024); } \
        else { _Pragma("unroll") for (int m = 0; m < 4; ++m) dst##8[m] = PG8_LD8(lds + PG8_SA(b, h) + aoff + m * 2048); } } while (0)
#define PG8_LDB(dst, b, h) do { if constexpr (MODE == 0) { _Pragma("unroll") for (int n = 0; n < 2; ++n) _Pragma("unroll") for (int k = 0; k < 2; ++k) dst[n][k] = *(const LAS bf16x8*)(lds + PG8_SB(b, h) + boff + n * 2048 + k * 1024); } \
        else { _Pragma("unroll") for (int n = 0; n < 2; ++n) dst##8[n] = PG8_LD8(lds + PG8_SB(b, h) + boff + n * 2048); } } while (0)
#define PG8_MMA(ai, bj, At, Bt) do { __builtin_amdgcn_s_setprio(1); \
        if constexpr (MODE == 0) { _Pragma("unroll") for (int m = 0; m < 4; ++m) _Pragma("unroll") for (int n = 0; n < 2; ++n) _Pragma("unroll") for (int k = 0; k < 2; ++k) \
            acc[ai][bj][m][n] = __builtin_amdgcn_mfma_f32_16x16x32_bf16(Bt[n][k], At[m][k], acc[ai][bj][m][n], 0, 0, 0); } \
        else { _Pragma("unroll") for (int m = 0; m < 4; ++m) _Pragma("unroll") for (int n = 0; n < 2; ++n) \
            asm volatile("v_mfma_f32_16x16x128_f8f6f4 %0, %1, %2, %0" : "+v"(acc[ai][bj][m][n]) : "v"(Bt##8[n]), "v"(At##8[m])); } \
        __builtin_amdgcn_s_setprio(0); } while (0)
#define PG8_WAIT_V(n) asm volatile("s_waitcnt vmcnt(" #n ")" ::: "memory")
#define PG8_WAIT_L(n) asm volatile("s_waitcnt lgkmcnt(" #n ")" ::: "memory")
#define PG8_BAR __builtin_amdgcn_s_barrier()
#define PG8_SCHED __builtin_amdgcn_sched_barrier(0)
    Unit cur, nxt; int ui = 0;
    if constexpr (Sched::TABLES) S.setup(lds, tid);
    if (!S.next(0, cur)) return;
    f32x4 acc[2][2][4][2];
#pragma unroll
    for (int a = 0; a < 2; ++a)
#pragma unroll
        for (int b = 0; b < 2; ++b)
#pragma unroll
            for (int m = 0; m < 4; ++m)
#pragma unroll
                for (int n = 0; n < 2; ++n) acc[a][b][m][n] = (f32x4){0.f, 0.f, 0.f, 0.f};
    const int sclB = Epi::SCALE_B, sclA = 0x7F7F7F7F;
    bf16x8 At[4][2], B0[2][2], B1[2][2]; v8i32 At8[4], B08[2], B18[2];
    unsigned o00, o01, o10, o11;
    o00 = (unsigned)S.arow(cur, Rp[0]) * lda2 + Cp2[0]; o01 = (unsigned)S.arow(cur, Rp[1]) * lda2 + Cp2[1];
    o10 = (unsigned)S.arow(cur, HALF + Rp[0]) * lda2 + Cp2[0]; o11 = (unsigned)S.arow(cur, HALF + Rp[1]) * lda2 + Cp2[1];
    const char* cB = cur.B;
#define PG8_EPITAB(u, slot) do { if constexpr (Epi::NTAB > 0) { if (wid >= 1 && wid <= Epi::NTAB) \
        __builtin_amdgcn_global_load_lds((const unsigned*)(E.tab_src(wid - 1, (u)) + lane * 16), (LAS unsigned*)(lds + EPIT_OFF + (slot) * EPIT_SLOT + (wid - 1) * 1024), 16, 0, 0); } } while (0)
    PG8_EPITAB(cur, 0);
    PG8_STAGE_B(PG8_SB(0, 0), cB); PG8_STAGE_B(PG8_SB(0, 1), cB + hstepB); PG8_STAGE_A(PG8_SA(0, 0), o00, o01, 0); PG8_STAGE_A(PG8_SA(0, 1), o10, o11, 0);
    if (wr == 1) PG8_BAR;
    PG8_WAIT_V(2); PG8_BAR;
    PG8_STAGE_B(PG8_SB(1, 0), cB + 128); PG8_STAGE_A(PG8_SA(1, 0), o00, o01, 128); PG8_STAGE_B(PG8_SB(1, 1), cB + hstepB + 128);
    PG8_WAIT_V(6); PG8_BAR;
    for (;;) {
        const bool has_next = S.next(ui + 1, nxt);
        const bool skipb1 = Epi::SKIP_B1_PN >= 0 && cur.pn == Epi::SKIP_B1_PN;
        unsigned n00 = o00, n01 = o01, n10 = o10, n11 = o11; const char* nB = cB;
        if (has_next) { nB = nxt.B;
            if (Sched::GATHERS && ui > 0) {
                const LAS int* tb = (const LAS int*)(lds + ROWT_OFF + ((ui + 1) & 1) * 1024);
                const int t00 = tb[Rp[0]], t01 = tb[Rp[1]], t10 = tb[HALF + Rp[0]], t11 = tb[HALF + Rp[1]];
                n00 = (unsigned)(t00 < 0 ? 0 : (t00 >> 2)) * lda2 + Cp2[0]; n01 = (unsigned)(t01 < 0 ? 0 : (t01 >> 2)) * lda2 + Cp2[1];
                n10 = (unsigned)(t10 < 0 ? 0 : (t10 >> 2)) * lda2 + Cp2[0]; n11 = (unsigned)(t11 < 0 ? 0 : (t11 >> 2)) * lda2 + Cp2[1];
            } else { n00 = (unsigned)S.arow(nxt, Rp[0]) * lda2 + Cp2[0]; n01 = (unsigned)S.arow(nxt, Rp[1]) * lda2 + Cp2[1];
                n10 = (unsigned)S.arow(nxt, HALF + Rp[0]) * lda2 + Cp2[0]; n11 = (unsigned)S.arow(nxt, HALF + Rp[1]) * lda2 + Cp2[1]; } }
        if (has_next) PG8_EPITAB(nxt, (ui + 1) % 3);
        if constexpr (Sched::GATHERS) { const int pm2 = S.pm_of(ui + 2);
            if (pm2 >= 0 && wid == 0) __builtin_amdgcn_global_load_lds((const unsigned*)(S.rowtab(pm2) + lane * 4), (LAS unsigned*)(lds + ROWT_OFF + (ui & 1) * 1024), 16, 0, 0); }
        for (int t = 0; t < nt; t += 2) {
            const bool last = (t == nt - 2);
            const unsigned kb1 = (unsigned)(t + 1) * 128u, kb2 = last ? 0u : (unsigned)(t + 2) * 128u;
            const unsigned x00 = last ? n00 : o00, x01 = last ? n01 : o01, x10 = last ? n10 : o10, x11 = last ? n11 : o11;
            const char* b2 = last ? nB : cB + (size_t)(t + 2) * 128; const char* b3 = b2 + 128;
            PG8_LDB(B0, 0, 0); PG8_LDB(B1, 0, 1); PG8_SCHED; PG8_LDA(At, 0, 0); PG8_STAGE_A(PG8_SA(1, 1), o10, o11, kb1);
            PG8_WAIT_V(8); PG8_WAIT_L(0); PG8_BAR; PG8_MMA(0, 0, At, B0); if (!skipb1) PG8_MMA(0, 1, At, B1); PG8_BAR; PG8_SCHED;
            PG8_LDA(At, 0, 1); PG8_STAGE_B(PG8_SB(0, 0), b2); PG8_STAGE_B(PG8_SB(0, 1), b2 + hstepB); PG8_STAGE_A(PG8_SA(0, 0), x00, x01, kb2);
            PG8_WAIT_V(8); PG8_WAIT_L(0); PG8_BAR; PG8_MMA(1, 0, At, B0); if (!skipb1) PG8_MMA(1, 1, At, B1); PG8_BAR; PG8_SCHED;
            PG8_LDB(B0, 1, 0); PG8_LDB(B1, 1, 1); PG8_SCHED; PG8_LDA(At, 1, 0); PG8_STAGE_A(PG8_SA(0, 1), x10, x11, kb2);
            PG8_WAIT_V(8); PG8_WAIT_L(0); PG8_BAR; PG8_MMA(0, 0, At, B0); if (!skipb1) PG8_MMA(0, 1, At, B1); PG8_BAR; PG8_SCHED;
            PG8_LDA(At, 1, 1); PG8_STAGE_B(PG8_SB(1, 0), b3); PG8_STAGE_B(PG8_SB(1, 1), b3 + hstepB); PG8_STAGE_A(PG8_SA(1, 0), x00, x01, kb2 + 128u);
            PG8_WAIT_V(8); PG8_WAIT_L(0); PG8_BAR; PG8_MMA(1, 0, At, B0); if (!skipb1) PG8_MMA(1, 1, At, B1); PG8_BAR; PG8_SCHED;
        }
        if (wr == 0) PG8_BAR;
        if constexpr (MODE == 1) asm volatile("s_nop 15\n\ts_nop 15" ::: "memory");
        E(acc, cur, wr, wc, fr, fq, (const LAS unsigned char*)(lds + EPIT_OFF + (ui % 3) * EPIT_SLOT));
        if (!has_next) break;
#pragma unroll
        for (int a = 0; a < 2; ++a)
#pragma unroll
            for (int b = 0; b < 2; ++b)
#pragma unroll
                for (int m = 0; m < 4; ++m)
#pragma unroll
                    for (int n = 0; n < 2; ++n) acc[a][b][m][n] = (f32x4){0.f, 0.f, 0.f, 0.f};
        cur = nxt; cB = nB; o00 = n00; o01 = n01; o10 = n10; o11 = n11; ++ui;
        if (wr == 1) PG8_BAR;
    }
    PG8_WAIT_V(0);
    PG8_BAR;
#undef PG8_SA
#undef PG8_EPITAB
#undef PG8_SB
#undef PG8_STAGE_A
#undef PG8_STAGE_B
#undef PG8_LDA
#undef PG8_LDB
#undef PG8_MMA
#undef PG8_LD8
#undef PG8_WAIT_V
#undef PG8_WAIT_L
#undef PG8_BAR
#undef PG8_SCHED
}

template <int NN> struct DenseOrder {
    static constexpr int nM = MTOK / BM, nwg = nM * NN; static constexpr bool TABLES = false, GATHERS = false;
    __device__ __forceinline__ void setup(LAS unsigned char*, int) const {}
    __device__ __forceinline__ int pm_of(int) const { return -1; }
    __device__ __forceinline__ const int* rowtab(int) const { return nullptr; }
    int G, c, K; const char* Bt;
    __device__ __forceinline__ void init(int K_, const void* Bt_, int G_, int c_) { G = G_; c = c_; K = K_; Bt = (const char*)Bt_; }
    __device__ __forceinline__ bool next(int i, Unit& u) const {
        const int L = i * G + c; if (L >= nwg) return false;
        constexpr int q = nwg / NXCD; static_assert(nwg % NXCD == 0, "units divide over the XCDs");
        const int wgid = (L % NXCD) * q + L / NXCD;
        constexpr int nig = WGM * NN; const int gid = wgid / nig, fm = gid * WGM, rem = wgid % nig;
        u.pm = fm + (rem & (WGM - 1)); u.pn = rem / WGM; u.e = 0; u.B = Bt + (size_t)u.pn * BM * K * 2; return true;
    }
    __device__ __forceinline__ int arow(const Unit& u, int r) const { return u.pm * BM + r; }
};
template <int NT, bool GATHER> struct MoeOrder {
    static constexpr bool TABLES = true, GATHERS = GATHER;
    int G, c, K, mt_lo, nmt, esz, rev; const int* mte; const int* tokrow; const char* Wt; size_t estride;
    LAS unsigned char* lds_;
    __device__ __forceinline__ void setup(LAS unsigned char* lds, int tid) { lds_ = lds; __syncthreads();
        for (int i = tid; i < nmt; i += 512) *(LAS int*)(lds + MTE_OFF + 4 * i) = mte[mt_lo + i];
        if (tid < UNITT_N) { int pm, pn; *(LAS int*)(lds + UNITT_OFF + 4 * tid) = place_calc(tid, pm, pn) ? (pm | (pn << 16)) : -1; }
        __syncthreads(); }
    __device__ __forceinline__ bool place(int i, int& pm, int& pn) const {
        if (i >= UNITT_N) return false;
        const int v = __builtin_amdgcn_readfirstlane(*(const LAS int*)(lds_ + UNITT_OFF + 4 * i)); if (v < 0) return false; pm = v & 0xffff; pn = v >> 16; return true; }
    __device__ __forceinline__ bool place_calc(int i, int& pm, int& pn) const {
        const long L = (long)i * G + c; const int nwg = nmt * NT; if (L >= (long)nwg) return false;
        int wgid = (int)L; { const int q = nwg / NXCD, r = nwg % NXCD, xcd = wgid % NXCD; int off = wgid / NXCD; if (rev) off = (xcd < r ? q + 1 : q) - 1 - off; wgid = (xcd < r ? xcd * (q + 1) : r * (q + 1) + (xcd - r) * q) + off; }
        constexpr int nig = WGM * NT; const int gid = wgid / nig, fm = gid * WGM, gsz = (nmt - fm) < WGM ? (nmt - fm) : WGM, rem = wgid % nig;
        if (gsz == WGM) { pm = mt_lo + fm + (rem & (WGM - 1)); pn = rem / WGM; } else { pm = mt_lo + fm + rem % gsz; pn = rem / gsz; }
        return true; }
    __device__ __forceinline__ bool next(int i, Unit& u) const {
        if (!place(i, u.pm, u.pn)) return false;
        const int e = __builtin_amdgcn_readfirstlane(*(const LAS int*)(lds_ + MTE_OFF + 4 * (u.pm - mt_lo)));
        u.e = e; u.B = Wt + (size_t)e * estride + (size_t)u.pn * BM * K * esz; return true;
    }
    __device__ __forceinline__ int pm_of(int i) const { int pm, pn; return place(i, pm, pn) ? pm : -1; }
    __device__ __forceinline__ const int* rowtab(int pm) const { return tokrow + (size_t)pm * BM; }
    __device__ __forceinline__ int arow(const Unit& u, int r) const { if (GATHER) { const int t = tokrow[u.pm * BM + r]; return t < 0 ? 0 : (t >> 2); } return (u.pm - mt_lo) * BM + r; }
};

struct EpiProj {
    static constexpr int SKIP_B1_PN = NP / 256 - 1; static constexpr bool PERM = true; static constexpr int SCALE_B = 0x7F7F7F7F, NTAB = 0;
    bf16_t* O;
    __device__ __forceinline__ const char* tab_src(int, const Unit&) const { return nullptr; }
    __device__ __forceinline__ void operator()(const f32x4 (&acc)[2][2][4][2], const Unit& u, int wr, int wc, int fr, int fq, const LAS unsigned char*) const {
        const int row0 = u.pm * BM + wr * 64 + fr, col0 = u.pn * BM + wc * 32 + 8 * fq;
#pragma unroll
        for (int ai = 0; ai < 2; ++ai)
#pragma unroll
            for (int m = 0; m < 4; ++m) { bf16_t* rowp = O + (size_t)(row0 + ai * HALF + m * 16) * NP + col0;
#pragma unroll
                for (int bj = 0; bj < 2; ++bj) { const f32x4 v0 = acc[ai][bj][m][0], v1 = acc[ai][bj][m][1];
                    u32x4 w; w.x = pk2(v0[0], v0[1]); w.y = pk2(v0[2], v0[3]); w.z = pk2(v1[0], v1[1]); w.w = pk2(v1[2], v1[3]);
                    *(u32x4*)(rowp + bj * HALF) = w; } }
    }
};
struct EpiRes {
    static constexpr int SKIP_B1_PN = -1; static constexpr bool PERM = false; static constexpr int SCALE_B = 0x7F7F7F7F, NTAB = 0;
    const float* X; float* O;
    __device__ __forceinline__ const char* tab_src(int, const Unit&) const { return nullptr; }
    __device__ __forceinline__ void operator()(const f32x4 (&acc)[2][2][4][2], const Unit& u, int wr, int wc, int fr, int fq, const LAS unsigned char*) const {
        const int row0 = u.pm * BM + wr * 64 + fr, col0 = u.pn * BM + wc * 32 + 4 * fq;
#pragma unroll
        for (int ai = 0; ai < 2; ++ai) { f32x4 xv[4][2][2];
#pragma unroll
            for (int m = 0; m < 4; ++m) { const size_t off = (size_t)(row0 + ai * HALF + m * 16) * DM + col0;
#pragma unroll
                for (int bj = 0; bj < 2; ++bj)
#pragma unroll
                    for (int n = 0; n < 2; ++n) xv[m][bj][n] = *(const f32x4*)(X + off + bj * HALF + n * 16); }
            asm volatile("" ::: "memory");
#pragma unroll
            for (int m = 0; m < 4; ++m) { const size_t off = (size_t)(row0 + ai * HALF + m * 16) * DM + col0;
#pragma unroll
                for (int bj = 0; bj < 2; ++bj)
#pragma unroll
                    for (int n = 0; n < 2; ++n) *(f32x4*)(O + off + bj * HALF + n * 16) = acc[ai][bj][m][n] + xv[m][bj][n]; }
            asm volatile("" ::: "memory"); }
    }
};
__device__ __forceinline__ float swiglu1(float g, float l1) {
    g = fminf(g, 7.0f); l1 = __builtin_amdgcn_fmed3f(l1, -6.0f, 8.0f);
    const float sg = __builtin_amdgcn_rcpf(1.0f + __builtin_amdgcn_exp2f(-1.702f * LOG2E * g));
    return (g * sg) * l1;
}
struct EpiSwiglu {
    static constexpr int SKIP_B1_PN = -1; static constexpr bool PERM = true; static constexpr int SCALE_B = 0x7A7A7A7A, NTAB = 2;
    const float* b1; unsigned char* ACT; int mt_lo; const float* rrow;
    __device__ __forceinline__ const char* tab_src(int k, const Unit& u) const { return k == 0 ? (const char*)(b1 + (size_t)u.e * 2048 + u.pn * BM) : (const char*)(rrow + (size_t)u.pm * BM); }
    __device__ __forceinline__ void operator()(const f32x4 (&acc)[2][2][4][2], const Unit& u, int wr, int wc, int fr, int fq, const LAS unsigned char* tb) const {
        const int row0 = (u.pm - mt_lo) * BM + wr * 64 + fr, col0 = u.pn * BM + wc * 32 + 8 * fq;
        f32x4 bv[2][2];
#pragma unroll
        for (int bj = 0; bj < 2; ++bj)
#pragma unroll
            for (int n = 0; n < 2; ++n) { bv[bj][n] = *(const LAS f32x4*)(tb + (wc * 32 + 8 * fq + bj * HALF + 4 * n) * 4); bv[bj][n][1] += 1.0f; bv[bj][n][3] += 1.0f; }
        float rr[2][4];
#pragma unroll
        for (int ai = 0; ai < 2; ++ai)
#pragma unroll
            for (int m = 0; m < 4; ++m) rr[ai][m] = *(const LAS float*)(tb + 1024 + (wr * 64 + fr + ai * HALF + m * 16) * 4) * 0.03125f;
#pragma unroll
        for (int ai = 0; ai < 2; ++ai)
#pragma unroll
            for (int bj = 0; bj < 2; ++bj) { unsigned wd[4];
#pragma unroll
                for (int m = 0; m < 4; ++m) { const f32x4 v0 = acc[ai][bj][m][0] * rr[ai][m] + bv[bj][0], v1 = acc[ai][bj][m][1] * rr[ai][m] + bv[bj][1];
                    wd[m] = pk4_fp8_nc(swiglu1(v0[0], v0[1]), swiglu1(v0[2], v0[3]), swiglu1(v1[0], v1[1]), swiglu1(v1[2], v1[3])); }
                const auto p = __builtin_amdgcn_permlane16_swap(wd[0], wd[1], false, false), q = __builtin_amdgcn_permlane16_swap(wd[2], wd[3], false, false);
                const auto lo = __builtin_amdgcn_permlane32_swap(p[0], q[0], false, false), hi = __builtin_amdgcn_permlane32_swap(p[1], q[1], false, false);
                u32x4 o; o.x = lo[0]; o.y = hi[0]; o.z = lo[1]; o.w = hi[1];
                *(u32x4*)(ACT + (size_t)(row0 + ai * HALF + fq * 16) * DFF + ((u.pn * BM + wc * 32) >> 1) + bj * (HALF / 2)) = o; }
    }
};
struct EpiMoeOut {
    static constexpr int SKIP_B1_PN = -1; static constexpr bool PERM = true; static constexpr int SCALE_B = 0x7A7A7A7A, NTAB = 3;
    const float* b2; const int* tokrow; const float* grow; unsigned char* Y;
    __device__ __forceinline__ const char* tab_src(int k, const Unit& u) const { return k == 0 ? (const char*)(b2 + (size_t)u.e * DM + u.pn * BM) : k == 1 ? (const char*)(tokrow + (size_t)u.pm * BM) : (const char*)(grow + (size_t)u.pm * BM); }
    __device__ __forceinline__ void operator()(const f32x4 (&acc)[2][2][4][2], const Unit& u, int wr, int wc, int fr, int fq, const LAS unsigned char* tb) const {
        const int col0 = u.pn * BM + wc * 32 + 8 * fq;
        f32x4 bv[2][2];
#pragma unroll
        for (int bj = 0; bj < 2; ++bj)
#pragma unroll
            for (int n = 0; n < 2; ++n) bv[bj][n] = *(const LAS f32x4*)(tb + (wc * 32 + 8 * fq + bj * HALF + 4 * n) * 4) * 32.0f;
        int tk[2][4]; float gg[2][4];
#pragma unroll
        for (int ai = 0; ai < 2; ++ai)
#pragma unroll
            for (int m = 0; m < 4; ++m) { const int rl = wr * 64 + fr + ai * HALF + m * 16; tk[ai][m] = *(const LAS int*)(tb + 1024 + rl * 4); gg[ai][m] = *(const LAS float*)(tb + 2048 + rl * 4); }
        const int colw = u.pn * BM + wc * 32 + 16 * (fq >> 1);
#pragma unroll
        for (int ai = 0; ai < 2; ++ai)
#pragma unroll
            for (int mp = 0; mp < 4; mp += 2) { const float gA = gg[ai][mp] * 0.5f, gB = gg[ai][mp + 1] * 0.5f;
                const int tks = (fq & 1) ? tk[ai][mp + 1] : tk[ai][mp];
#pragma unroll
                for (int bj = 0; bj < 2; ++bj) {
                    const f32x4 a0 = (acc[ai][bj][mp][0] + bv[bj][0]) * gA, a1 = (acc[ai][bj][mp][1] + bv[bj][1]) * gA, b0 = (acc[ai][bj][mp + 1][0] + bv[bj][0]) * gB, b1 = (acc[ai][bj][mp + 1][1] + bv[bj][1]) * gB;
                    const unsigned ax = pk4_fp8(a0[0], a0[1], a0[2], a0[3]), ay = pk4_fp8(a1[0], a1[1], a1[2], a1[3]), bx = pk4_fp8(b0[0], b0[1], b0[2], b0[3]), by = pk4_fp8(b1[0], b1[1], b1[2], b1[3]);
                    const auto px = __builtin_amdgcn_permlane16_swap(ax, bx, false, false), py = __builtin_amdgcn_permlane16_swap(ay, by, false, false);
                    u32x4 o; o.x = px[0]; o.y = py[0]; o.z = px[1]; o.w = py[1];
                    if (tks >= 0) *(u32x4*)(Y + (size_t)tks * DM + colw + bj * HALF) = o; } }
    }
};
}

#define XB_TMO      128
#define XB_XCNT(j)  (256  + 64 * (j))
#define XB_XSUB(j)  (1280 + 64 * (j))
#define XB_XGEN(j)  (2304 + 64 * (j))
#define XB_TOP      3328
#define XB_TOPGEN   3392
#define XCD_BAR_WORDS 3456
#define XB_SPIN_CAP (1u << 26)

__device__ __forceinline__ unsigned xb_ld(unsigned* p)              { return __hip_atomic_load(p, __ATOMIC_RELAXED, __HIP_MEMORY_SCOPE_AGENT); }
__device__ __forceinline__ unsigned xb_add(unsigned* p, unsigned v) { return __hip_atomic_fetch_add(p, v, __ATOMIC_RELAXED, __HIP_MEMORY_SCOPE_AGENT); }
__device__ __forceinline__ unsigned xb_xcc_id() { return (unsigned)__builtin_amdgcn_s_getreg((3 << 11) | 20) & 0xFu; }
#define XB_SPIN(cond, bar) do { unsigned _sp = 0; while (cond) { __builtin_amdgcn_s_sleep(1); \
    if ((++_sp & 255u) == 0u) { if (xb_ld(&(bar)[XB_TMO])) break; if (_sp > XB_SPIN_CAP) { atomicAdd(&(bar)[XB_TMO], 1u); break; } } } } while (0)
struct XcdBarrier { unsigned* bar; unsigned x; volatile LAS unsigned* st; };
__device__ __forceinline__ XcdBarrier xcd_barrier_post(unsigned* bar, volatile LAS unsigned* st) {
    XcdBarrier b; b.bar = bar; b.x = xb_xcc_id(); b.st = st;
    if (threadIdx.x == 0) (void)xb_add(&bar[XB_XCNT(b.x)], 1u);
    return b;
}
__device__ __forceinline__ void xcd_barrier_complete(unsigned* bar, unsigned x, unsigned& nloc, unsigned& nx) {
    const unsigned G = gridDim.x * gridDim.y * gridDim.z;
    unsigned sum, cnt, mine, sp = 0u;
    for (;;) {
        sum = 0u; cnt = 0u; mine = 0u;
#pragma unroll
        for (unsigned j = 0; j < 16; ++j) { const unsigned c = xb_ld(&bar[XB_XCNT(j)]); sum += c; cnt += (c > 0u) ? 1u : 0u; mine = (j == x) ? c : mine; }
        if (sum == G) break;
        __builtin_amdgcn_s_sleep(1);
        if ((++sp & 255u) == 0u) { if (xb_ld(&bar[XB_TMO])) break; if (sp > XB_SPIN_CAP) { atomicAdd(&bar[XB_TMO], 1u); break; } }
    }
    nloc = mine > 0u ? mine : 1u; nx = cnt > 0u ? cnt : 1u;
}
__device__ __forceinline__ void xcd_barrier(const XcdBarrier& b) {
    asm volatile("s_waitcnt vmcnt(0)" ::: "memory");
    __syncthreads();
    if (threadIdx.x == 0) {
        unsigned* bar = b.bar;
        __builtin_amdgcn_s_waitcnt(0);
        unsigned nloc = b.st[0], nx = b.st[1];
        if (nloc == 0u) { xcd_barrier_complete(bar, b.x, nloc, nx); b.st[0] = nloc; b.st[1] = nx; }
        const unsigned old = xb_add(&bar[XB_XSUB(b.x)], 1u);
        const unsigned gen = old / nloc;
        if (old + 1u == (gen + 1u) * nloc) {
            __builtin_amdgcn_fence(__ATOMIC_RELEASE, "agent");
            asm volatile("s_waitcnt vmcnt(0)" ::: "memory");
            const unsigned og = xb_add(&bar[XB_TOP], 1u);
            const unsigned tg = og / nx;
            if (og + 1u == (tg + 1u) * nx) xb_add(&bar[XB_TOPGEN], 1u);
            else XB_SPIN(xb_ld(&bar[XB_TOPGEN]) == tg, bar);
            __builtin_amdgcn_fence(__ATOMIC_ACQUIRE, "agent");
            xb_add(&bar[XB_XGEN(b.x)], 1u);
            asm volatile("s_waitcnt vmcnt(0)" ::: "memory");
        } else {
            XB_SPIN(xb_ld(&bar[XB_XGEN(b.x)]) == gen, bar);
            __builtin_amdgcn_fence(__ATOMIC_ACQUIRE, "agent");
            asm volatile("s_waitcnt vmcnt(0)" ::: "memory");
        }
    }
    __syncthreads();
}

struct Args { const float* in[16]; float* out; unsigned char* ws; int ph_lo, ph_hi; };
struct Frame {
    LAS unsigned char* lds;
    int tid, lane, wave, G;
    unsigned char* ws;
    const __attribute__((address_space(4))) Args* ap;
    float* out;
};
#define FIN(k) ((const float*)(const GAS float*)(F.ap->in[k]))
#define Fx FIN(0)
#define Fg1 FIN(1)
#define Fw_in FIN(2)
#define Frel_bias FIN(3)
#define Fkg FIN(4)
#define Fkb FIN(5)
#define Fgn FIN(6)
#define Fw_out FIN(7)
#define Fg2 FIN(8)
#define Fw_router FIN(9)
#define Fb_router FIN(10)
#define Fw1 FIN(11)
#define Fb1 FIN(12)
#define Fw2 FIN(13)
#define Fb2 FIN(14)
#define Fgf FIN(15)

__device__ __forceinline__ int win_src_col(int n) {
    if (n < 512) return n;
    if (n < 1024) return 2632 + (n - 512);
    if (n < 1536) return 512 + (n - 1024);
    if (n < 2048) return 1024 + (n - 1536);
    if (n < 2560) return 1536 + (n - 2048);
    if (n < 2816) return 2120 + (n - 2560);
    if (n < 3072) return 2376 + (n - 2816);
    if (n < 3584) return 3144 + (n - 3072);
    if (n < 3648) return 2048 + (n - 3584);
    if (n < 3656) return 2112 + (n - 3648);
    return -1;
}
__device__ __forceinline__ void tr_item(const float* W, int ldw, int K, bf16_t* WT, LAS float* scr, int k0, int n0, int lane, int sc, float scale) {
    float tv[32];
#pragma unroll
    for (int i = 0; i < 32; ++i) { const int kk = 2 * i + (lane >> 5); tv[i] = sc >= 0 ? W[(size_t)(k0 + kk) * ldw + sc] * scale : 0.f; }
#pragma unroll
    for (int i = 0; i < 32; ++i) { const int kk = 2 * i + (lane >> 5); scr[kk * 33 + (lane & 31)] = tv[i]; }
    LDS_WAIT(); asm volatile("" ::: "memory");
    const int c = lane & 7;
#pragma unroll
    for (int j = 0; j < 4; ++j) { const int n = (lane >> 3) + 8 * j; const LAS float* s = scr + (8 * c) * 33 + n;
        u32x4 o; o.x = pk2(s[0 * 33], s[1 * 33]); o.y = pk2(s[2 * 33], s[3 * 33]); o.z = pk2(s[4 * 33], s[5 * 33]); o.w = pk2(s[6 * 33], s[7 * 33]);
        *(u32x4*)(WT + (size_t)(n0 + n) * K + k0 + 8 * c) = o; }
    LDS_WAIT(); asm volatile("" ::: "memory");
}
__device__ __forceinline__ void tr_item_f8x2(const float* W, int ldw, int K, unsigned char* WT, LAS float* scr, int k0, int n0, int lane, float scale) {
    float tv[2][32];
#pragma unroll
    for (int t = 0; t < 2; ++t)
#pragma unroll
        for (int i = 0; i < 32; ++i) { const int kk = 2 * i + (lane >> 5); tv[t][i] = W[(size_t)(k0 + kk) * ldw + n0 + 32 * t + (lane & 31)] * scale; }
#pragma unroll
    for (int t = 0; t < 2; ++t) {
#pragma unroll
        for (int i = 0; i < 32; ++i) { const int kk = 2 * i + (lane >> 5); scr[kk * 33 + (lane & 31)] = tv[t][i]; }
        LDS_WAIT(); asm volatile("" ::: "memory");
        const int c = lane & 7;
#pragma unroll
        for (int j = 0; j < 4; ++j) { const int n = (lane >> 3) + 8 * j; const LAS float* sp = scr + (8 * c) * 33 + n;
            u32x2 o; o.x = pk4_fp8(sp[0 * 33], sp[1 * 33], sp[2 * 33], sp[3 * 33]); o.y = pk4_fp8(sp[4 * 33], sp[5 * 33], sp[6 * 33], sp[7 * 33]);
            *(u32x2*)(WT + (size_t)(n0 + 32 * t + n) * K + k0 + 8 * c) = o; }
        LDS_WAIT(); asm volatile("" ::: "memory"); }
}
__device__ __forceinline__ void rms_row_to_bf16(const float* xrow, const float* gain, bf16_t* orow, int lane) {
    const f32x4* xr = (const f32x4*)xrow + lane; const f32x4* gr = (const f32x4*)gain + lane;
    f32x4 v[4]; float s = 0.f;
#pragma unroll
    for (int j = 0; j < 4; ++j) { v[j] = xr[64 * j]; s += (v[j].x * v[j].x + v[j].y * v[j].y) + (v[j].z * v[j].z + v[j].w * v[j].w); }
    const float r = rsqrtf(wave_sum(s) * (1.f / DM) + 1e-5f);
    unsigned long long* o8 = (unsigned long long*)orow + lane;
#pragma unroll
    for (int j = 0; j < 4; ++j) { const f32x4 g = gr[64 * j]; o8[64 * j] = (unsigned long long)pk2(v[j].x * r * g.x, v[j].y * r * g.y) | ((unsigned long long)pk2(v[j].z * r * g.z, v[j].w * r * g.w) << 32); }
}
__device__ __forceinline__ void p0_prologue(Frame& F) {
    LAS float* scr = (LAS float*)(F.lds + F.wave * 16384);
    const int gw = blockIdx.x * 8 + F.wave, NGW = F.G * 8;
    bf16_t* WinT = (bf16_t*)(F.ws + WS_WIN); bf16_t* WoutT = (bf16_t*)(F.ws + WS_WOUT);
    constexpr int I_IN = 16 * (NP / 32), I_OUT = 16 * 32;
    for (int it = gw; it < I_IN + I_OUT; it += NGW) {
        if (it < I_IN) { const int kb = it / (NP / 32), nb = it % (NP / 32); const int n = nb * 32 + (F.lane & 31);
            tr_item(Fw_in, 3656, DM, WinT, scr, kb * 64, nb * 32, F.lane, win_src_col(n), n < 512 ? QA_SCALE : 1.0f); }
        else { const int r = it - I_IN; const int kb = r / 32, nb = r % 32; tr_item(Fw_out, DM, DM, WoutT, scr, kb * 64, nb * 32, F.lane, nb * 32 + (F.lane & 31), 1.0f); }
    }
    { bf16_t* WRH = (bf16_t*)(F.ws + WS_WRH); bf16_t* WRL = (bf16_t*)(F.ws + WS_WRL);
      for (int i = blockIdx.x * 512 + F.tid; i < 64 * 64 * 8; i += F.G * 512) { const int j = i & 7, ln = (i >> 3) & 63, kk = i >> 9; const int d = 16 * kk + 8 * (ln >> 5) + j, e = ln & 31;
          const float v = Fg2[d] * Fw_router[d * 32 + e]; const bf16_t hi = f2bf(v); WRH[i] = hi; WRL[i] = f2bf(v - bf2f(hi)); } }
    bf16_t* H = (bf16_t*)(F.ws + WS_H);
    for (int m = gw; m < MTOK; m += 2 * NGW) {
        const int m2 = m + NGW; const float* g1p = Fg1;
        const f32x4* xa = (const f32x4*)(Fx + (size_t)m * DM) + F.lane; const f32x4* xb = (const f32x4*)(Fx + (size_t)(m2 < MTOK ? m2 : m) * DM) + F.lane; const f32x4* gr = (const f32x4*)g1p + F.lane;
        f32x4 va[4], vb[4]; float sa = 0.f, sb = 0.f;
#pragma unroll
        for (int j = 0; j < 4; ++j) { va[j] = xa[64 * j]; vb[j] = xb[64 * j]; }
#pragma unroll
        for (int j = 0; j < 4; ++j) { sa += (va[j].x * va[j].x + va[j].y * va[j].y) + (va[j].z * va[j].z + va[j].w * va[j].w); sb += (vb[j].x * vb[j].x + vb[j].y * vb[j].y) + (vb[j].z * vb[j].z + vb[j].w * vb[j].w); }
        const float ra = rsqrtf(wave_sum(sa) * (1.f / DM) + 1e-5f), rb = rsqrtf(wave_sum(sb) * (1.f / DM) + 1e-5f);
        unsigned long long* oa = (unsigned long long*)(H + (size_t)m * DM) + F.lane; unsigned long long* ob = (unsigned long long*)(H + (size_t)(m2 < MTOK ? m2 : m) * DM) + F.lane;
#pragma unroll
        for (int j = 0; j < 4; ++j) { const f32x4 g = gr[64 * j];
            oa[64 * j] = (unsigned long long)pk2(va[j].x * ra * g.x, va[j].y * ra * g.y) | ((unsigned long long)pk2(va[j].z * ra * g.z, va[j].w * ra * g.w) << 32);
            if (m2 < MTOK) ob[64 * j] = (unsigned long long)pk2(vb[j].x * rb * g.x, vb[j].y * rb * g.y) | ((unsigned long long)pk2(vb[j].z * rb * g.z, vb[j].w * rb * g.w) << 32); }
    }
}

__device__ __forceinline__ float ret_log2g(int h) { return log2f(1.0f - exp2f(-5.0f - (float)h)); }
__device__ __forceinline__ int tsw(int row, int tok) { return row * 72 + ((((tok >> 3) ^ ((row >> 3) & 7)) << 3) | (tok & 7)); }
__device__ __forceinline__ void prep_phase(Frame& F) {
    LAS bf16_t* TK = (LAS bf16_t*)(F.lds);
    LAS bf16_t* TV = (LAS bf16_t*)(F.lds + 36864);
    const bf16_t* proj = (const bf16_t*)(F.ws + WS_PROJ);
    bf16_t* kiln = (bf16_t*)(F.ws + WS_KILN); float* wbuf = (float*)(F.ws + WS_WBUF);
    bf16_t* qr = (bf16_t*)(F.ws + WS_QR); bf16_t* kr = (bf16_t*)(F.ws + WS_KR); bf16_t* kTz = (bf16_t*)(F.ws + WS_KTZ);
    bf16_t* vTa = (bf16_t*)(F.ws + WS_VTA); bf16_t* vTb = (bf16_t*)(F.ws + WS_VTB);
    const int tid = F.tid, lane = F.lane;
    LAS f32x2* SC = (LAS f32x2*)(F.lds + 36864 + 73728);
    const int lt = tid >> 3, ls = tid & 7;
    float kgv[8], kbv[8];
    { const f32x4 g0 = *(const f32x4*)(Fkg + 8 * ls), g1 = *(const f32x4*)(Fkg + 8 * ls + 4), b0 = *(const f32x4*)(Fkb + 8 * ls), b1 = *(const f32x4*)(Fkb + 8 * ls + 4);
      kgv[0] = g0.x; kgv[1] = g0.y; kgv[2] = g0.z; kgv[3] = g0.w; kgv[4] = g1.x; kgv[5] = g1.y; kgv[6] = g1.z; kgv[7] = g1.w;
      kbv[0] = b0.x; kbv[1] = b0.y; kbv[2] = b0.z; kbv[3] = b0.w; kbv[4] = b1.x; kbv[5] = b1.y; kbv[6] = b1.z; kbv[7] = b1.w; }
    float lgh[4];
#pragma unroll
    for (int h = 0; h < 4; ++h) lgh[h] = ret_log2g(h);
    for (int u = blockIdx.x; u < NB * 128; u += F.G) {
        const int b = u >> 7, c = u & 127; const int tok0 = b * SEQ + c * 64;
        for (int i = 0; i < 4; ++i) { const int idx = tid + 512 * i, tl = idx >> 5, j = idx & 31; const int pos = c * 64 + tl;
            const float inv = exp2f(-(float)j * (13.287712379549449f / 31.0f)); const float ang = (float)pos * inv;
            double t = (double)ang * 0.15915494309189535; t -= rint(t); const float tf = (float)t;
            SC[idx] = (f32x2){__builtin_amdgcn_cosf(tf), __builtin_amdgcn_sinf(tf)}; }
        { const int tok = tok0 + lt; const bf16_t* pr = proj + (size_t)tok * NP;
          const u32x4 kv = *(const u32x4*)(pr + C_KI + 8 * ls); const unsigned kw[4] = {kv.x, kv.y, kv.z, kv.w};
          float xv[8]; float sm = 0.f;
#pragma unroll
          for (int e = 0; e < 4; ++e) { xv[2 * e] = __uint_as_float(kw[e] << 16); xv[2 * e + 1] = __uint_as_float(kw[e] & 0xffff0000u); sm += xv[2 * e] + xv[2 * e + 1]; }
          sm += __shfl_xor(sm, 1); sm += __shfl_xor(sm, 2); sm += __shfl_xor(sm, 4); const float mean = sm * (1.f / 64.f); float sq = 0.f;
#pragma unroll
          for (int e = 0; e < 8; ++e) { xv[e] -= mean; sq += xv[e] * xv[e]; }
          sq += __shfl_xor(sq, 1); sq += __shfl_xor(sq, 2); sq += __shfl_xor(sq, 4); const float rs = rsqrtf(sq * (1.f / 64.f) + 1e-6f);
          u32x4 o; o.x = pk2(xv[0] * rs * kgv[0] + kbv[0], xv[1] * rs * kgv[1] + kbv[1]); o.y = pk2(xv[2] * rs * kgv[2] + kbv[2], xv[3] * rs * kgv[3] + kbv[3]);
          o.z = pk2(xv[4] * rs * kgv[4] + kbv[4], xv[5] * rs * kgv[5] + kbv[5]); o.w = pk2(xv[6] * rs * kgv[6] + kbv[6], xv[7] * rs * kgv[7] + kbv[7]);
          const int tb = tok & (SEQ - 1);
          *(u32x4*)(kiln + (size_t)(tok - tb) * 64 + ((size_t)((tb >> 5) * 4 + (ls >> 1)) * 64 + (tb & 31) + 32 * (ls & 1)) * 8) = o;
          if (ls == 0) { const u32x4 wv4 = *(const u32x4*)(pr + C_WI); f32x4 w0, w1; w0.x = __uint_as_float(wv4.x << 16) * IDX_W_SCALE; w0.y = __uint_as_float(wv4.x & 0xffff0000u) * IDX_W_SCALE; w0.z = __uint_as_float(wv4.y << 16) * IDX_W_SCALE; w0.w = __uint_as_float(wv4.y & 0xffff0000u) * IDX_W_SCALE;
              w1.x = __uint_as_float(wv4.z << 16) * IDX_W_SCALE; w1.y = __uint_as_float(wv4.z & 0xffff0000u) * IDX_W_SCALE; w1.z = __uint_as_float(wv4.w << 16) * IDX_W_SCALE; w1.w = __uint_as_float(wv4.w & 0xffff0000u) * IDX_W_SCALE;
              *(f32x4*)(wbuf + (size_t)tok * 8) = w0; *(f32x4*)(wbuf + (size_t)tok * 8 + 4) = w1; } }
        __syncthreads();
        u32x4 ra[4], rb[4];
#pragma unroll
        for (int i = 0; i < 4; ++i) { const int id = tid + 512 * i, which = id >> 10, rem = id & 1023, tl = rem >> 4, hq = rem & 15;
            const bf16_t* pr = proj + (size_t)(tok0 + tl) * NP + (which ? C_KB : C_QB) + (hq >> 2) * 64 + 8 * (hq & 3); ra[i] = *(const u32x4*)(pr); rb[i] = *(const u32x4*)(pr + 32); }
#pragma unroll
        for (int i = 0; i < 4; ++i) { const int id = tid + 512 * i, which = id >> 10, rem = id & 1023, tl = rem >> 4, hq = rem & 15, h = hq >> 2, jg = hq & 3;
            const unsigned aw[4] = {ra[i].x, ra[i].y, ra[i].z, ra[i].w}, bw[4] = {rb[i].x, rb[i].y, rb[i].z, rb[i].w};
            float o1[8], o2[8];
#pragma unroll
            for (int e = 0; e < 8; ++e) { const float x1 = (e & 1) ? __uint_as_float(aw[e >> 1] & 0xffff0000u) : __uint_as_float(aw[e >> 1] << 16), x2 = (e & 1) ? __uint_as_float(bw[e >> 1] & 0xffff0000u) : __uint_as_float(bw[e >> 1] << 16);
                const f32x2 cs = SC[tl * 32 + 8 * jg + e]; const float sc = which ? 0.125f : 1.0f;
                o1[e] = (x1 * cs.x - x2 * cs.y) * sc; o2[e] = (x2 * cs.x + x1 * cs.y) * sc; }
            bf16_t* dst = (which ? kr : qr) + (size_t)(tok0 + tl) * 256 + h * 64 + 8 * jg;
            u32x4 w1; w1.x = pk2(o1[0], o1[1]); w1.y = pk2(o1[2], o1[3]); w1.z = pk2(o1[4], o1[5]); w1.w = pk2(o1[6], o1[7]);
            u32x4 w2; w2.x = pk2(o2[0], o2[1]); w2.y = pk2(o2[2], o2[3]); w2.z = pk2(o2[4], o2[5]); w2.w = pk2(o2[6], o2[7]);
            *(u32x4*)(dst) = w1; *(u32x4*)(dst + 32) = w2;
            if (which) { const float z = exp2f((float)(63 - tl) * lgh[h]);
#pragma unroll
                for (int e = 0; e < 8; ++e) { TK[tsw(h * 64 + 8 * jg + e, tl)] = f2bf(o1[e] * z); TK[tsw(h * 64 + 8 * jg + e + 32, tl)] = f2bf(o2[e] * z); } } }
        __syncthreads();
        { const int row = tid >> 1, hf = tid & 1;
#pragma unroll
          for (int i = 0; i < 4; ++i) { const u32x4 v = *(const LAS u32x4*)(TK + tsw(row, hf * 32 + i * 8)); *(u32x4*)(kTz + (size_t)(b * 256 + row) * SEQ + c * 64 + hf * 32 + i * 8) = v; } }
        for (int which = 1; which < 2; ++which) {
            __syncthreads();
            const int colbase = which ? C_VB : C_VA;
            for (int i = 0; i < 8; ++i) { const int p = tid + 512 * i, tl = p >> 6, seg = p & 63; const u32x4 v = *(const u32x4*)(proj + (size_t)(tok0 + tl) * NP + colbase + seg * 8);
                const unsigned w4[4] = {v.x, v.y, v.z, v.w};
#pragma unroll
                for (int e = 0; e < 4; ++e) { TV[tsw(seg * 8 + 2 * e, tl)] = (bf16_t)(w4[e] & 0xffffu); TV[tsw(seg * 8 + 2 * e + 1, tl)] = (bf16_t)(w4[e] >> 16); } }
            __syncthreads();
            bf16_t* dst = which ? vTb : vTa;
            for (int i = 0; i < 8; ++i) { const int p = tid + 512 * i, row = p >> 3, sg = p & 7; const u32x4 v = *(const LAS u32x4*)(TV + tsw(row, sg * 8));
                *(u32x4*)(dst + (size_t)(b * 512 + row) * SEQ + c * 64 + sg * 8) = v; }
            { const int h = F.wave >> 1, l31 = lane & 31, hf = lane >> 5; bf16_t* KVo = (bf16_t*)(F.ws + WS_KV) + ((size_t)((b * 4 + h) * 128 + c) * 128) * 64;
              bf16x8 bfr[2][4];
#pragma unroll
              for (int nt = 0; nt < 2; ++nt)
#pragma unroll
                  for (int kk = 0; kk < 4; ++kk) bfr[nt][kk] = *(const LAS bf16x8*)(TK + tsw(h * 64 + 32 * nt + l31, 16 * kk + 8 * hf));
#pragma unroll
              for (int m2 = 0; m2 < 2; ++m2) { const int mt = (F.wave & 1) * 2 + m2; bf16x8 afr[4];
#pragma unroll
                  for (int kk = 0; kk < 4; ++kk) afr[kk] = *(const LAS bf16x8*)(TV + tsw(h * 128 + 32 * mt + l31, 16 * kk + 8 * hf));
#pragma unroll
                  for (int nt = 0; nt < 2; ++nt) { f32x16 acc = {};
#pragma unroll
                      for (int kk = 0; kk < 4; ++kk) acc = __builtin_amdgcn_mfma_f32_32x32x16_bf16(afr[kk], bfr[nt][kk], acc, 0, 0, 0);
                      int lofs = 4 * hf * 64 + l31; asm volatile("" : "+v"(lofs)); bf16_t* op = KVo + lofs;
#pragma unroll
                      for (int a = 0; a < 16; ++a) op[(32 * mt + crow(a, 0)) * 64 + 32 * nt] = f2bf(acc[a]); } } }
        }
        __syncthreads();
    }
}

constexpr int ICAP = 896, ICJ = ICAP / 64;
__device__ __forceinline__ unsigned compact_top(LAS unsigned* buf, int n, int lane, int target) {
    unsigned x[ICJ];
#pragma unroll
    for (int j = 0; j < ICJ; ++j) x[j] = buf[lane + 64 * j];
    unsigned a = ~0u, o = 0u;
#pragma unroll
    for (int j = 0; j < ICJ; ++j) { const bool in = (lane + 64 * j) < n; x[j] = in ? x[j] : 0u; a &= in ? x[j] : ~0u; o |= x[j]; }
#pragma unroll
    for (int sft = 1; sft < 64; sft <<= 1) { a &= (unsigned)__shfl_xor((int)a, sft); o |= (unsigned)__shfl_xor((int)o, sft); }
    int bit = 31 - __clz((int)((a ^ o) | 1u));
    unsigned P = (bit >= 31) ? 0u : (a & ~((2u << bit) - 1u));
    for (; bit >= 0; --bit) { const unsigned T = P | (1u << bit); int c = 0;
#pragma unroll
        for (int j = 0; j < ICJ; ++j) c += __popcll(__ballot(x[j] >= T));
        if (c >= target) { P = T; if (c == target) break; } }
    int base = 0;
#pragma unroll
    for (int j = 0; j < ICJ; ++j) { const bool k = x[j] >= P; const unsigned long long mk = __ballot(k); const int pos = base + (int)__builtin_amdgcn_mbcnt_hi((unsigned)(mk >> 32), __builtin_amdgcn_mbcnt_lo((unsigned)mk, 0u));
        if (k) buf[pos] = x[j]; base += __popcll(mk); }
    LDS_WAIT();
    return P;
}
template <int NJ> __device__ __forceinline__ void select_bits(const LAS unsigned* buf, int n, int lane, LAS unsigned* MASK, unsigned qbit) {
    unsigned x[NJ];
#pragma unroll
    for (int j = 0; j < NJ; ++j) x[j] = buf[lane + 64 * j];
    unsigned a = ~0u, o = 0u;
#pragma unroll
    for (int j = 0; j < NJ; ++j) { const bool in = (lane + 64 * j) < n; x[j] = in ? x[j] : 0u; a &= in ? x[j] : ~0u; o |= x[j]; }
    unsigned P = 0u;
    if (n > 256) {
#pragma unroll
        for (int sft = 1; sft < 64; sft <<= 1) { a &= (unsigned)__shfl_xor((int)a, sft); o |= (unsigned)__shfl_xor((int)o, sft); }
        int bit = 31 - __clz((int)((a ^ o) | 1u));
        P = (bit >= 31) ? 0u : (a & ~((2u << bit) - 1u));
        for (; bit >= 0; --bit) { const unsigned T = P | (1u << bit); int c = 0;
#pragma unroll
            for (int j = 0; j < NJ; ++j) c += __popcll(__ballot(x[j] >= T));
            if (c >= 256) { P = T; if (c == 256) break; } } }
    P = P ? P : 1u;
#pragma unroll
    for (int j = 0; j < NJ; ++j) if (x[j] >= P) { const int kidx = 8191 - (int)(x[j] & 0x1FFFu);
        const int key = kidx & 63, wq = 16 * ((key >> 5) & 1) + (key & 3) + 4 * ((key >> 3) & 3), hb = (key >> 2) & 1;
        __hip_atomic_fetch_or(MASK + ((kidx >> 6) * 32 + wq) * 2 + hb, qbit, __ATOMIC_RELAXED, __HIP_MEMORY_SCOPE_WORKGROUP); }
}
__device__ __forceinline__ float relu1(float x) { const int xi = __float_as_int(x); return __int_as_float(xi > 0 ? xi : 0); }
__device__ __forceinline__ void index_phase(Frame& F) {
    LAS unsigned* CAND = (LAS unsigned*)(F.lds);
    LAS unsigned* MASK = (LAS unsigned*)(F.lds + 32 * ICAP * 4);
    LAS unsigned* TRASH = (LAS unsigned*)(F.lds + 32 * ICAP * 4 + 32768);
    const bf16_t* proj = (const bf16_t*)(F.ws + WS_PROJ); const bf16_t* kiln = (const bf16_t*)(F.ws + WS_KILN); const float* wbuf = (const float*)(F.ws + WS_WBUF);
    unsigned* maskg = (unsigned*)(F.ws + WS_MASK);
    const int tid = F.tid, lane = F.lane, wave = F.wave, kcol = lane & 31, hf = lane >> 5;
    bf16x8 afn[4]; f32x4 wvn[2][2];
    auto unit_of = [&](int i) { return (i & 1) ? i * F.G + (F.G - 1 - (int)blockIdx.x) : i * F.G + (int)blockIdx.x; };
    auto request = [&](int r) __attribute__((always_inline)) { const int c = 127 - (r >> 4), b = (r & 15) >> 1, half = r & 1; const int q0 = b * SEQ + c * 64 + half * 32;
        const int m = kcol; const int ql = 2 * ((m >> 2) & 1) + (m >> 4), hd = 4 * ((m >> 3) & 1) + (m & 3);
        const bf16_t* qrow = proj + (size_t)(q0 + 4 * wave + ql) * NP + C_QI + hd * 64 + hf * 8;
#pragma unroll
        for (int kk = 0; kk < 4; ++kk) afn[kk] = *(const bf16x8*)(qrow + 16 * kk);
#pragma unroll
        for (int e = 0; e < 2; ++e) { const f32x4* wp = (const f32x4*)(wbuf + (size_t)(q0 + 4 * wave + 2 * hf + e) * 8); wvn[e][0] = wp[0]; wvn[e][1] = wp[1]; } };
    if (unit_of(0) < NB * 128 * 2) request(unit_of(0));
    for (int i = 0;; ++i) {
        const int r = unit_of(i);
        if (r >= NB * 128 * 2) break;
        const int c = 127 - (r >> 4), b = (r & 15) >> 1, half = r & 1;
        const int L = (c + 1) * 64; const int q0 = b * SEQ + c * 64 + half * 32;
        __syncthreads();
        for (int j = tid; j < 128 * 64; j += 512) MASK[j] = 0u;
        bf16x8 af[4];
#pragma unroll
        for (int kk = 0; kk < 4; ++kk) af[kk] = afn[kk];
        float wv[2][8];
#pragma unroll
        for (int e = 0; e < 2; ++e) { const f32x4 a = wvn[e][0], bq = wvn[e][1];
            wv[e][0] = a.x; wv[e][1] = a.y; wv[e][2] = a.z; wv[e][3] = a.w; wv[e][4] = bq.x; wv[e][5] = bq.y; wv[e][6] = bq.z; wv[e][7] = bq.w; }
        unsigned cnt[4], thr[4];
        const bf16_t* kp = kiln + (size_t)(b * SEQ) * 64 + lane * 8;
        const int npair = L >> 6;
        bf16x8 f0[2][4], f1[2][4];
        for (int pass = 0; pass < 2; ++pass) {
        unsigned firstmask = 0xFu, guessed = 0u;
#pragma unroll
        for (int q = 0; q < 4; ++q) { cnt[q] = 0u; thr[q] = 0u; }
#define IDX_LDPAIR(dst) do { _Pragma("unroll") for (int s_ = 0; s_ < 2; ++s_) _Pragma("unroll") for (int kk = 0; kk < 4; ++kk) dst[s_][kk] = *(const bf16x8*)(ldp + (s_ * 4 + kk) * 512); ldp += 8 * 512; } while (0)
        const bf16_t* ldp = kp;
        const unsigned trash_b = (unsigned)(32 * ICAP + 8192 + tid) * 4u;
        IDX_LDPAIR(f0); IDX_LDPAIR(f1);
        f32x16 accA[2], accB[2];
#pragma unroll
        for (int kk = 0; kk < 4; ++kk)
#pragma unroll
            for (int s_ = 0; s_ < 2; ++s_) accA[s_] = __builtin_amdgcn_mfma_f32_32x32x16_bf16(af[kk], f0[s_][kk], kk ? accA[s_] : (f32x16){}, 0, 0, 0);
        auto step = [&](f32x16 (&ac)[2], f32x16 (&an)[2], bf16x8 (&fm)[2][4], bf16x8 (&fl)[2][4], const int p, const bool valid) __attribute__((always_inline)) {
            IDX_LDPAIR(fl);
#pragma unroll
            for (int kk = 0; kk < 4; ++kk)
#pragma unroll
                for (int s_ = 0; s_ < 2; ++s_) an[s_] = __builtin_amdgcn_mfma_f32_32x32x16_bf16(af[kk], fm[s_][kk], kk ? an[s_] : (f32x16){}, 0, 0, 0);
            float scv[2][2];
#pragma unroll
            for (int s_ = 0; s_ < 2; ++s_)
#pragma unroll
                for (int e = 0; e < 2; ++e) { float sc = 0.f;
#pragma unroll
                    for (int j = 0; j < 8; ++j) sc = fmaf(wv[e][j], relu1(ac[s_][8 * e + j]), sc);
                    scv[s_][e] = sc; }
            unsigned pk[4]; const unsigned nidx = (unsigned)(8191 - (p * 64 + lane));
#pragma unroll
            for (int e = 0; e < 2; ++e) { const auto rr = __builtin_amdgcn_permlane32_swap(__float_as_uint(scv[0][e]), __float_as_uint(scv[1][e]), false, false);
#pragma unroll
                for (int u = 0; u < 2; ++u) { const unsigned uu = rr[u]; const unsigned key = uu ^ ((unsigned)((int)uu >> 31) | 0x80000000u);
                    pk[2 * u + e] = (key & 0xFFFFE000u) | nidx; } }
#pragma unroll
            for (int q = 0; q < 4; ++q) { unsigned te = thr[q]; const unsigned sb = (unsigned)((4 * wave + q) * ICAP * 4) + cnt[q] * 4u; unsigned n, t_;
                asm volatile("v_cmp_gt_u32_e64 vcc, %[pk], %[te]\n\ts_nop 1\n\tv_mbcnt_lo_u32_b32 %[t], vcc_lo, 0\n\tv_mbcnt_hi_u32_b32 %[t], vcc_hi, %[t]\n\tv_lshl_add_u32 %[t], %[t], 2, %[sb]\n\t"
                             "v_cndmask_b32_e32 %[t], %[tr], %[t], vcc\n\tds_write_b32 %[t], %[pk]\n\ts_bcnt1_i32_b64 %[n], vcc"
                             : [t] "=&v"(t_), [n] "=s"(n) : [pk] "v"(pk[q]), [te] "s"(te), [sb] "s"(sb), [tr] "v"(trash_b) : "vcc", "scc", "memory");
                cnt[q] += n; }
#pragma unroll
            for (int k_ = 0; k_ < 8; ++k_) { __builtin_amdgcn_sched_group_barrier(0x008, 1, 0); __builtin_amdgcn_sched_group_barrier(0x002, 12, 0); }
        };
        auto compact = [&]() __attribute__((always_inline)) {
            const bool over = (cnt[0] > (unsigned)(ICAP - 128)) | (cnt[1] > (unsigned)(ICAP - 128)) | (cnt[2] > (unsigned)(ICAP - 128)) | (cnt[3] > (unsigned)(ICAP - 128));
            if (over) { LDS_WAIT();
#pragma unroll
                for (int q = 0; q < 4; ++q) if (cnt[q] > (unsigned)(ICAP - 128)) { unsigned target = 256u;
                    if (pass == 0 && ((firstmask >> q) & 1u)) { unsigned k0 = (unsigned)(512.0f * (float)cnt[q] / (float)L); k0 = k0 < 32u ? 32u : k0; if (k0 < 256u) { target = k0; guessed |= 1u << q; } }
                    firstmask &= ~(1u << q);
                    const unsigned P = compact_top(CAND + (4 * wave + q) * ICAP, (int)cnt[q], lane, (int)target); cnt[q] = target; thr[q] = P - 1u; } }
        };
        { int p = 0;
          for (; p + 1 < npair; p += 2) { step(accA, accB, f1, f0, p, true); step(accB, accA, f0, f1, p + 1, true); compact(); }
          if (p < npair) { step(accA, accB, f1, f0, p, true); compact(); } }
#undef IDX_LDPAIR
        bool ok = true;
#pragma unroll
        for (int q = 0; q < 4; ++q) ok = ok && !(((guessed >> q) & 1u) && cnt[q] < 256u);
        if (ok) break;
        LDS_WAIT();
        }
        LDS_WAIT();
        if (unit_of(i + 1) < NB * 128 * 2) request(unit_of(i + 1));
        __syncthreads();
#pragma unroll
        for (int q = 0; q < 4; ++q) { const LAS unsigned* bufq = CAND + (4 * wave + q) * ICAP;
            if (cnt[q] <= 576u) select_bits<9>(bufq, (int)cnt[q], lane, MASK, 1u << (4 * wave + q)); else select_bits<ICJ>(bufq, (int)cnt[q], lane, MASK, 1u << (4 * wave + q)); }
        LDS_WAIT();
        __syncthreads();
        { u32x4* mg = (u32x4*)(maskg + ((size_t)(b * 256 + c * 2 + half) * 128) * 64); const int ntb = 4 * ((c >> 2) + 1);
          for (int j = tid; j < ntb * 16; j += 512) mg[j] = *(const LAS u32x4*)(MASK + j * 4); }
    }
}

__device__ __forceinline__ int wg_ticket(Frame& F, unsigned* ctr) {
    volatile LAS int* w = (volatile LAS int*)(F.lds + LDSCTL_OFF + 256);
    __syncthreads();
    if (F.tid == 0) *w = (int)__hip_atomic_fetch_add(ctr, 1u, __ATOMIC_RELAXED, __HIP_MEMORY_SCOPE_AGENT);
    __syncthreads();
    return *w;
}
__device__ __forceinline__ void ret_scan_phase(Frame& F) {
    bf16_t* KV = (bf16_t*)(F.ws + WS_KV);
    unsigned* qc = (unsigned*)(F.ws + WS_CTL) + CW_Q_SCAN;
    for (int tk = wg_ticket(F, qc); tk < NB * 4 * 8192 / 2048; tk = wg_ticket(F, qc)) { const int el = (tk * 512 + F.tid) * 4;
        const int bh = el >> 13, r = el & 8191, h = bh & 3;
        const float dl = exp2f(64.0f * ret_log2g(h));
        u32x2* p = (u32x2*)(KV + (size_t)bh * 128 * 8192 + r); float P0 = 0.f, P1 = 0.f, P2 = 0.f, P3 = 0.f;
        for (int c = 0; c < 128; c += 16) { u32x2 t[16];
#pragma unroll
            for (int i = 0; i < 16; ++i) t[i] = p[(size_t)(c + i) * 2048];
#pragma unroll
            for (int i = 0; i < 16; ++i) { u32x2 o; o.x = pk2(P0, P1); o.y = pk2(P2, P3); p[(size_t)(c + i) * 2048] = o;
                P0 = dl * P0 + __uint_as_float(t[i].x << 16); P1 = dl * P1 + __uint_as_float(t[i].x & 0xffff0000u); P2 = dl * P2 + __uint_as_float(t[i].y << 16); P3 = dl * P3 + __uint_as_float(t[i].y & 0xffff0000u); } }
    }
}
__device__ __forceinline__ void ret_out_phase(Frame& F) {
    const bf16_t* vTb = (const bf16_t*)(F.ws + WS_VTB); const bf16_t* qr = (const bf16_t*)(F.ws + WS_QR); const bf16_t* kr = (const bf16_t*)(F.ws + WS_KR);
    const bf16_t* KV = (const bf16_t*)(F.ws + WS_KV); bf16_t* proj = (bf16_t*)(F.ws + WS_PROJ);
    const int lane = F.lane, l31 = lane & 31, hf = lane >> 5;
    unsigned* qc = (unsigned*)(F.ws + WS_CTL) + CW_Q_ROUT;
    for (int tk = wg_ticket(F, qc); tk < NB * 128 * 4 / 8; tk = wg_ticket(F, qc)) { const int u = tk * 8 + F.wave;
        const int b = u >> 9, c = (u >> 2) & 127, h = u & 3; const int tok0 = b * SEQ + c * 64;
        const float lg = ret_log2g(h);
        const bf16_t* vt = vTb + (size_t)(b * 512 + h * 128) * SEQ + c * 64;
        const bf16_t* st = KV + ((size_t)((b * 4 + h) * 128 + c) * 128) * 64;
        for (int nt = 0; nt < 2; ++nt) {
            const int npos = 32 * nt + l31; const int tok = tok0 + npos;
            bf16x8 qf[4];
#pragma unroll
            for (int kk = 0; kk < 4; ++kk) qf[kk] = *(const bf16x8*)(qr + (size_t)tok * 256 + h * 64 + 16 * kk + 8 * hf);
            f32x16 y[4];
#pragma unroll
            for (int dt = 0; dt < 4; ++dt) { y[dt] = (f32x16){};
#pragma unroll
                for (int kk = 0; kk < 4; ++kk) y[dt] = __builtin_amdgcn_mfma_f32_32x32x16_bf16(*(const bf16x8*)(st + (size_t)(32 * dt + l31) * 64 + 16 * kk + 8 * hf), qf[kk], y[dt], 0, 0, 0); }
            const float xi = exp2f((float)(npos + 1) * lg);
#pragma unroll
            for (int dt = 0; dt < 4; ++dt)
#pragma unroll
                for (int a = 0; a < 16; ++a) y[dt][a] *= xi;
            for (int mt = 0; mt <= nt; ++mt) {
                f32x16 s = {};
#pragma unroll
                for (int kk = 0; kk < 4; ++kk) { const bf16x8 kf = *(const bf16x8*)(kr + (size_t)(tok0 + 32 * mt + l31) * 256 + h * 64 + 16 * kk + 8 * hf); s = __builtin_amdgcn_mfma_f32_32x32x16_bf16(kf, qf[kk], s, 0, 0, 0); }
#pragma unroll
                for (int a = 0; a < 16; ++a) { const int diff = npos - (32 * mt + crow(a, hf)); s[a] = diff >= 0 ? s[a] * exp2f((float)diff * lg) : 0.f; }
                const bf16x8 p0 = pack8(s[0], s[1], s[2], s[3], s[4], s[5], s[6], s[7]), p1 = pack8(s[8], s[9], s[10], s[11], s[12], s[13], s[14], s[15]);
#pragma unroll
                for (int dt = 0; dt < 4; ++dt) { const bf16_t* vrow = vt + (size_t)(32 * dt + l31) * SEQ + 32 * mt + 4 * hf;
                    const u32x2 a0 = *(const u32x2*)(vrow), a1 = *(const u32x2*)(vrow + 8), a2 = *(const u32x2*)(vrow + 16), a3 = *(const u32x2*)(vrow + 24);
                    u32x4 f0; f0.x = a0.x; f0.y = a0.y; f0.z = a1.x; f0.w = a1.y; u32x4 f1; f1.x = a2.x; f1.y = a2.y; f1.z = a3.x; f1.w = a3.y;
                    y[dt] = __builtin_amdgcn_mfma_f32_32x32x16_bf16(__builtin_bit_cast(bf16x8, f0), p0, y[dt], 0, 0, 0);
                    y[dt] = __builtin_amdgcn_mfma_f32_32x32x16_bf16(__builtin_bit_cast(bf16x8, f1), p1, y[dt], 0, 0, 0); }
            }
            float sm = 0.f;
#pragma unroll
            for (int dt = 0; dt < 4; ++dt)
#pragma unroll
                for (int a = 0; a < 16; ++a) sm += y[dt][a];
            sm += __shfl_xor(sm, 32); const float mean = sm * (1.f / 128.f); float sq = 0.f;
#pragma unroll
            for (int dt = 0; dt < 4; ++dt)
#pragma unroll
                for (int a = 0; a < 16; ++a) { const float d = y[dt][a] - mean; sq += d * d; }
            sq += __shfl_xor(sq, 32); const float rstd = rsqrtf(sq * (1.f / 128.f) + 1e-6f);
            LAS unsigned char* yt = F.lds + F.wave * 17408 + npos * 272 + 8 * hf;
#pragma unroll
            for (int dt = 0; dt < 4; ++dt)
#pragma unroll
                for (int i4 = 0; i4 < 4; ++i4) { u32x2 w; w.x = pk2((y[dt][4 * i4] - mean) * rstd, (y[dt][4 * i4 + 1] - mean) * rstd); w.y = pk2((y[dt][4 * i4 + 2] - mean) * rstd, (y[dt][4 * i4 + 3] - mean) * rstd);
                    *(LAS u32x2*)(yt + (32 * dt + 8 * i4) * 2) = w; }
        }
        LDS_WAIT();
        { const int sg = lane & 15, tq = lane >> 4; const f32x4 g0 = *(const f32x4*)(Fgn + h * 128 + 8 * sg), g1 = *(const f32x4*)(Fgn + h * 128 + 8 * sg + 4);
          const float gnv[8] = {g0.x, g0.y, g0.z, g0.w, g1.x, g1.y, g1.z, g1.w};
#pragma unroll 4
          for (int it = 0; it < 16; ++it) { const int tl = it * 4 + tq; bf16_t* prow = proj + (size_t)(tok0 + tl) * NP + h * 128 + 8 * sg;
              const u32x4 gv = *(const u32x4*)(prow + C_GB); const u32x4 yv = *(const LAS u32x4*)(F.lds + F.wave * 17408 + tl * 272 + sg * 16);
              const unsigned gw[4] = {gv.x, gv.y, gv.z, gv.w}, yw[4] = {yv.x, yv.y, yv.z, yv.w}; unsigned ow[4];
#pragma unroll
              for (int e = 0; e < 4; ++e) { const float ga = __uint_as_float(gw[e] << 16), gb = __uint_as_float(gw[e] & 0xffff0000u);
                  const float sa = ga * __builtin_amdgcn_rcpf(1.0f + __builtin_amdgcn_exp2f(-LOG2E * ga)), sb = gb * __builtin_amdgcn_rcpf(1.0f + __builtin_amdgcn_exp2f(-LOG2E * gb));
                  ow[e] = pk2(__uint_as_float(yw[e] << 16) * gnv[2 * e] * sa, __uint_as_float(yw[e] & 0xffff0000u) * gnv[2 * e + 1] * sb); }
              u32x4 o; o.x = ow[0]; o.y = ow[1]; o.z = ow[2]; o.w = ow[3]; *(u32x4*)(prow + C_VB) = o; } }
        LDS_WAIT();
    }
}

namespace attn_body {
using bf16=__hip_bfloat16;
using bf16x8=__attribute__((ext_vector_type(8)))short;
using s16x4=__attribute__((ext_vector_type(4)))short;
using f32x16=__attribute__((ext_vector_type(16)))float;
using u32x4=__attribute__((ext_vector_type(4)))unsigned;
constexpr int BATCH=8,NHEAD=8,SEQ=8192,D=64,DM=3840;
constexpr int NW=8,QBLK=32,QB=QBLK*NW,KVBLK=64,NQB=SEQ/QB;
constexpr int ATTN_PITCH=DM, ATTN_UNIT_ROWS=QB;
__device__ __forceinline__ int crow(int r,int hi){return (r&3)+8*(r>>2)+4*hi;}
#define SBAR() __builtin_amdgcn_sched_barrier(0)
typedef const __attribute__((address_space(4))) unsigned long long* MaskP;
constexpr int BT_OFF=86016, BT_STRIDE=352;
constexpr int NSLOT=3, SLOTB=8192;
constexpr int LDS_K=0, LDS_V=NSLOT*SLOTB, LDS_WS=2*NSLOT*SLOTB, LDS_OST=LDS_WS+NW*64*4, LDS_BYTES=LDS_OST+NW*4096;
constexpr float C2=0.125f*1.4426950408889634f;
__device__ __forceinline__ void glds16(const void*gsrc,unsigned lds_dst){unsigned keep;
  asm volatile("s_mov_b32 %0, m0\n\ts_mov_b32 m0, %2\n\ts_nop 0\n\tglobal_load_lds_dwordx4 %1, off\n\ts_mov_b32 m0, %0":"=&s"(keep):"v"(gsrc),"s"(lds_dst):"memory");}
__device__ __forceinline__ float max3f(float a,float b,float c){float r;asm("v_max3_f32 %0, %1, %2, %3":"=v"(r):"v"(a),"v"(b),"v"(c));return r;}
__device__ __forceinline__ float max2f(float a,float b){float r;asm("v_max_f32_e32 %0, %1, %2":"=v"(r):"v"(a),"v"(b));return r;}
__device__ __forceinline__ float fadd_s(float a,float b){float r;asm("v_add_f32_e32 %0, %1, %2":"=v"(r):"v"(a),"v"(b));return r;}
__device__ __forceinline__ float fsub_s(float a,float b){float r;asm("v_sub_f32_e32 %0, %1, %2":"=v"(r):"v"(a),"v"(b));return r;}
typedef float f32x2_t __attribute__((ext_vector_type(2))); typedef __bf16 bf16x2_t __attribute__((ext_vector_type(2)));
__device__ __forceinline__ unsigned cvtpk_s(float lo,float hi){f32x2_t v={lo,hi};bf16x2_t b=__builtin_convertvector(v,bf16x2_t);return __builtin_bit_cast(unsigned,b);}
#define WAIT_BAR(N) do{ asm volatile("":::"memory"); __builtin_amdgcn_s_waitcnt(0x0070|(N)); __builtin_amdgcn_s_barrier(); asm volatile("":::"memory"); }while(0)

__device__ __forceinline__ void qkt(f32x16&p0,f32x16&p1,const char*Kslot,const bf16x8*qr,const f32x16&negm,int r32,int hi){
  const char*kb=Kslot+hi*1024+r32*16;
  #pragma unroll
  for(int d0=0;d0<4;++d0){
    const bf16x8 b0=*reinterpret_cast<const bf16x8*>(kb+d0*2048);
    const bf16x8 b1=*reinterpret_cast<const bf16x8*>(kb+d0*2048+512);
    if(d0==0){p0=__builtin_amdgcn_mfma_f32_32x32x16_bf16(b0,qr[0],negm,0,0,0);p1=__builtin_amdgcn_mfma_f32_32x32x16_bf16(b1,qr[0],negm,0,0,0);}
    else{p0=__builtin_amdgcn_mfma_f32_32x32x16_bf16(b0,qr[d0],p0,0,0,0);p1=__builtin_amdgcn_mfma_f32_32x32x16_bf16(b1,qr[d0],p1,0,0,0);}}
}
typedef __attribute__((address_space(3))) const char* lds_cptr;
typedef short v4i16_t __attribute__((ext_vector_type(4)));
__device__ __forceinline__ void kload8(bf16x8*kf,lds_cptr kp){
  kf[0]=*(const __attribute__((address_space(3))) bf16x8*)(kp);      kf[1]=*(const __attribute__((address_space(3))) bf16x8*)(kp+512);
  kf[2]=*(const __attribute__((address_space(3))) bf16x8*)(kp+2048); kf[3]=*(const __attribute__((address_space(3))) bf16x8*)(kp+2560);
  kf[4]=*(const __attribute__((address_space(3))) bf16x8*)(kp+4096); kf[5]=*(const __attribute__((address_space(3))) bf16x8*)(kp+4608);
  kf[6]=*(const __attribute__((address_space(3))) bf16x8*)(kp+6144); kf[7]=*(const __attribute__((address_space(3))) bf16x8*)(kp+6656);
}
__device__ __forceinline__ void kload2(bf16x8*kf,lds_cptr kp,int j){ kf[2*j]=*(const __attribute__((address_space(3))) bf16x8*)(kp+j*2048); kf[2*j+1]=*(const __attribute__((address_space(3))) bf16x8*)(kp+j*2048+512); }
__device__ __forceinline__ s16x4 vtr(lds_cptr p){ return __builtin_bit_cast(s16x4,__builtin_amdgcn_ds_read_tr16_b64_v4i16((__attribute__((address_space(3))) v4i16_t*)p)); }
__device__ __forceinline__ float rowmax(const f32x16&p0,const f32x16&p1){
  float a=max3f(p0[0],p0[1],p1[0]),b=max3f(p0[2],p0[3],p1[1]);a=max3f(a,p1[2],p1[3]);
  #pragma unroll
  for(int r=4;r<16;r+=4){a=max3f(a,p0[r],p0[r+1]);b=max3f(b,p0[r+2],p0[r+3]);a=max3f(a,p1[r],p1[r+1]);b=max3f(b,p1[r+2],p1[r+3]);}
  const float m=max2f(a,b);
  auto rr=__builtin_amdgcn_permlane32_swap(__float_as_uint(m),__float_as_uint(m),false,false);
  return max2f(__uint_as_float(rr[0]),__uint_as_float(rr[1]));
}
__device__ __forceinline__ void pv(f32x16*o,int vb,bf16x8 pa0,bf16x8 pa1,bf16x8 pa2,bf16x8 pa3){
  #pragma unroll
  for(int d0=0;d0<2;++d0){s16x4 lo[4],hi[4];
    #pragma unroll
    for(int ks=0;ks<4;++ks){
      asm volatile("ds_read_b64_tr_b16 %0,%1 offset:%c2":"=&v"(lo[ks]):"v"(vb),"i"(d0*4096+ks*1024):"memory");
      asm volatile("ds_read_b64_tr_b16 %0,%1 offset:%c2":"=&v"(hi[ks]):"v"(vb),"i"(d0*4096+ks*1024+512):"memory");}
    asm volatile("s_waitcnt lgkmcnt(0)":::"memory");SBAR();
    #define PK(k) (bf16x8){lo[k][0],lo[k][1],lo[k][2],lo[k][3],hi[k][0],hi[k][1],hi[k][2],hi[k][3]}
    o[d0]=__builtin_amdgcn_mfma_f32_32x32x16_bf16(pa0,PK(0),o[d0],0,0,0);
    o[d0]=__builtin_amdgcn_mfma_f32_32x32x16_bf16(pa1,PK(1),o[d0],0,0,0);
    o[d0]=__builtin_amdgcn_mfma_f32_32x32x16_bf16(pa2,PK(2),o[d0],0,0,0);
    o[d0]=__builtin_amdgcn_mfma_f32_32x32x16_bf16(pa3,PK(3),o[d0],0,0,0);
    #undef PK
  }
}

#ifndef ATTN_STORE16
#define ATTN_STORE16(p,v) (*(u32x4*)(p)=(v))
#endif
template<int THRL> __device__ __forceinline__ void attn_unit(int b,int h,int qb,const bf16*Q,const bf16*__restrict__ K,const bf16*__restrict__ V,bf16*O,MaskP maskA,char*shm){
  const int tid=threadIdx.x,lane=tid&63,r32=lane&31,hi=lane>>5; const int wid=__builtin_amdgcn_readfirstlane(tid>>6);
  const long rowbase=(long)b*SEQ; const int q0=qb*QB;
  const bf16*Qw=Q+(rowbase+q0+wid*QBLK)*DM+h*D;
  const bf16*Kh=K+rowbase*DM+h*D,*Vh=V+rowbase*DM+h*D;
  const unsigned lds0=(unsigned)(uintptr_t)shm;
  float*wsf=(float*)(shm+LDS_WS)+wid*64;
  const bf16*ksrc=Kh+(long)lane*DM+wid*8;
  const bf16*vsrc=Vh+(long)(16*(wid&3)+(lane>>2))*DM+(wid>>2)*32+(lane&3)*8;
  const unsigned kdst=lds0+LDS_K+wid*1024, vdst=lds0+LDS_V+wid*1024;
  #define DMA_K(t,slot) glds16(ksrc+(long)(t)*KVBLK*DM,(unsigned)__builtin_amdgcn_readfirstlane(kdst+(slot)))
  #define DMA_V(t,slot) glds16(vsrc+(long)(t)*KVBLK*DM,(unsigned)__builtin_amdgcn_readfirstlane(vdst+(slot)))
  const int vb0=(int)(lds0+LDS_V)+((lane>>4)&1)*32+(lane&3)*8+(4*hi+((lane&15)>>2))*64;
  const char*Kbase=shm+LDS_K; bf16x8 kf[8];
  const lds_cptr shm3=(lds_cptr)shm; const lds_cptr kp0=shm3+LDS_K+hi*1024+r32*16; const lds_cptr vp0=shm3+LDS_V+((lane>>4)&1)*32+(lane&3)*8+(4*hi+((lane&15)>>2))*64;
  const int NT=(q0+QB)/KVBLK;
  DMA_K(0,0);DMA_V(0,0);DMA_K(1,SLOTB);
  bf16x8 qr[4];
  #pragma unroll
  for(int d0=0;d0<4;++d0)qr[d0]=*reinterpret_cast<const bf16x8*>(&Qw[(long)r32*DM+d0*16+hi*8]);
  float mhat=0.f,l_reg=0.f;f32x16 o[2];o[0]=f32x16{};o[1]=f32x16{};f32x16 negm=f32x16{};asm volatile("":"+v"(negm));
  const int qrel=wid*QBLK+r32;
  const MaskP mrow=maskA+((long)(b*256+(q0>>5)+wid)*128)*32;
  const __attribute__((address_space(3))) float*bt3=(const __attribute__((address_space(3))) float*)((__attribute__((address_space(3))) const char*)shm+BT_OFF)+h*BT_STRIDE;
  unsigned tch0=0u,tch1=0u,tch2=0u,tch3=0u;
  #define MTOUCH(t) do{ asm volatile(""::"s"(tch0),"s"(tch1),"s"(tch2),"s"(tch3)); const MaskP tp_=mrow+(long)((t)+1)*32; \
      asm volatile("s_load_dword %0, %4, 0x0\n\ts_load_dword %1, %4, 0x40\n\ts_load_dword %2, %4, 0x80\n\ts_load_dword %3, %4, 0xc0":"=&s"(tch0),"=&s"(tch1),"=&s"(tch2),"=&s"(tch3):"s"(tp_)); }while(0)
  #define MLOAD(MA,t) unsigned long long MA[16]; { const MaskP mq_=mrow+(long)(t)*32; _Pragma("unroll") for(int r=0;r<16;++r) MA[r]=mq_[r]; }
  #define CMASK(P0,P1,t,MA) do{ const MaskP mp_=mrow+(long)(t)*32; \
    if((t)>=NT-6){ const int ln_=(int)__builtin_amdgcn_mbcnt_hi(~0u,__builtin_amdgcn_mbcnt_lo(~0u,0u)); const int rb_=64*(t)+4*(ln_>>5)-(q0+wid*QBLK+(ln_&31)); \
      _Pragma("unroll") for(int r=0;r<16;++r){ const int rel_=rb_+(r&3)+8*(r>>2); const int i0_=(rel_<-91?-91:rel_)+91, i1_=(rel_+32<-91?-91:rel_+32)+91; P0[r]+=bt3[i0_]; P1[r]+=bt3[i1_]; if((r&3)==3){ asm volatile("s_waitcnt lgkmcnt(0)":"+v"(P0),"+v"(P1)::"memory"); } } } \
    _Pragma("unroll") for(int r=0;r<16;++r) P0[r]=__builtin_amdgcn_inverse_ballot_w64(MA[r])?P0[r]:-INFINITY; \
    _Pragma("unroll") for(int r=0;r<16;++r) P1[r]=__builtin_amdgcn_inverse_ballot_w64(mp_[16+r])?P1[r]:-INFINITY; }while(0)
  bool resc=false;
  #define START(P0,P1) do{ const float rm=rowmax(P0,P1); resc=false; \
    { const float dl=(rm>0.f)?rm:0.f; mhat=fadd_s(mhat,dl); \
      _Pragma("unroll") for(int r=0;r<16;++r){P0[r]=fsub_s(P0[r],dl);P1[r]=fsub_s(P1[r],dl);} \
      _Pragma("unroll") for(int r=0;r<16;++r)negm[r]=-mhat; asm volatile("":"+v"(negm)); } \
    _Pragma("unroll") for(int r=0;r<16;++r)P0[r]=__builtin_amdgcn_exp2f(P0[r]); }while(0)
  #define RESC() do{ if(resc){ asm volatile("s_waitcnt lgkmcnt(0)":::"memory"); \
      _Pragma("unroll") for(int d_=0;d_<2;++d_) _Pragma("unroll") for(int r=0;r<16;++r)o[d_][r]*=wsf[crow(r,hi)]; } }while(0)
  f32x16 pA0,pA1,pB0,pB1;
  int sl_prev=0,sl_cur=0,sl_next=SLOTB;
  #define ROT() do{sl_prev=sl_cur;sl_cur=sl_next;sl_next=(sl_next==(NSLOT-1)*SLOTB)?0:sl_next+SLOTB;}while(0)
  DMA_K(2,2*SLOTB);
  WAIT_BAR(3);
  qkt(pA0,pA1,Kbase,qr,negm,r32,hi);asm volatile("s_nop 15\n\ts_nop 7":"+v"(pA0),"+v"(pA1));{ MLOAD(m0_,0); CMASK(pA0,pA1,0,m0_); }
  START(pA0,pA1);
  _Pragma("unroll") for(int r=0;r<16;++r)pA1[r]=__builtin_amdgcn_exp2f(pA1[r]);
  WAIT_BAR(0);
  DMA_K(3,0);DMA_V(1,SLOTB);
  ROT();
  kload8(kf,kp0+sl_cur);
  WAIT_BAR(2);
  s16x4 vlo[8],vhi[8]; u32x4 pw0,pw1,pw2,pw3;
  #define PKW(P,B) cvtpk_s(P[B],P[B+1])
  #define PAF(k) __builtin_bit_cast(bf16x8,pw##k)
  #define VFR(i) (bf16x8){vlo[i][0],vlo[i][1],vlo[i][2],vlo[i][3],vhi[i][0],vhi[i][1],vhi[i][2],vhi[i][3]}
  #define PIN(x) asm volatile("":"+v"(x))
  #define MX3(a,b,c) __builtin_fmaxf(__builtin_fmaxf((a),(b)),(c))
  #define GAPA(MF,A0,A1,A2,A3,W0,W1,PW) do{ MF; sacc+=A0; sacc+=A1; sacc+=A2; sacc+=A3; PIN(sacc); W0; W1; PIN(PW); SBAR(); }while(0)
  #define EX(v) __builtin_amdgcn_exp2f(v)
  #define GAPB(MF,X,B) do{ MF; X[B]=EX(X[B]); X[B+1]=EX(X[B+1]); X[B+2]=EX(X[B+2]); X[B+3]=EX(X[B+3]); PIN(X); SBAR(); }while(0)
  #define VRD(i) do{ vlo[i]=vtr(vp_+(((i)>>2)*4096+((i)&3)*1024)); vhi[i]=vtr(vp_+(((i)>>2)*4096+((i)&3)*1024+512)); }while(0)
  #define KRD(G,j) do{ if(G){ kload2(kf,kp0+sl_next,j); SBAR(); } }while(0)
  #define STEP(C0,C1,P0,P1,t,GK,GV,GL) do{ SBAR(); MTOUCH(t); MLOAD(mA_,t); SBAR(); \
    const lds_cptr vp_=vp0+sl_prev; \
    VRD(0); SBAR(); float sacc=(P0[0]+P0[1]); \
    GAPA(C0=__builtin_amdgcn_mfma_f32_32x32x16_bf16(kf[0],qr[0],negm,0,0,0), P0[2],P0[3],P0[4],P0[5],     pw0[0]=PKW(P0,0), pw0[1]=PKW(P0,2), pw0); \
    VRD(4); SBAR(); GAPA(C1=__builtin_amdgcn_mfma_f32_32x32x16_bf16(kf[1],qr[0],negm,0,0,0), P0[6],P0[7],P0[8],P0[9],     pw0[2]=PKW(P0,4), pw0[3]=PKW(P0,6), pw0); \
    VRD(1); SBAR(); GAPA(C0=__builtin_amdgcn_mfma_f32_32x32x16_bf16(kf[2],qr[1],C0,0,0,0),   P0[10],P0[11],P0[12],P0[13], pw1[0]=PKW(P0,8), pw1[1]=PKW(P0,10), pw1); \
    VRD(5); SBAR(); GAPA(C1=__builtin_amdgcn_mfma_f32_32x32x16_bf16(kf[3],qr[1],C1,0,0,0),   P0[14],P0[15],P1[0],P1[1],   pw1[2]=PKW(P0,12),pw1[3]=PKW(P0,14), pw1); \
    VRD(2); SBAR(); GAPA(C0=__builtin_amdgcn_mfma_f32_32x32x16_bf16(kf[4],qr[2],C0,0,0,0),   P1[2],P1[3],P1[4],P1[5],     pw2[0]=PKW(P1,0), pw2[1]=PKW(P1,2), pw2); \
    VRD(6); SBAR(); GAPA(C1=__builtin_amdgcn_mfma_f32_32x32x16_bf16(kf[5],qr[2],C1,0,0,0),   P1[6],P1[7],P1[8],P1[9],     pw2[2]=PKW(P1,4), pw2[3]=PKW(P1,6), pw2); \
    VRD(3); SBAR(); GAPA(C0=__builtin_amdgcn_mfma_f32_32x32x16_bf16(kf[6],qr[3],C0,0,0,0),   P1[10],P1[11],P1[12],P1[13], pw3[0]=PKW(P1,8), pw3[1]=PKW(P1,10), pw3); \
    VRD(7); SBAR(); GAPA(C1=__builtin_amdgcn_mfma_f32_32x32x16_bf16(kf[7],qr[3],C1,0,0,0),   P1[14],P1[15],0.f,0.f,       pw3[2]=PKW(P1,12),pw3[3]=PKW(P1,14), pw3); \
    l_reg+=sacc; \
    if(GK){DMA_K((t)+3,sl_cur);} if(GV){DMA_V((t)+1,sl_next);} \
    CMASK(C0,C1,t,mA_); \
    { float a=MX3(C0[0],C0[1],C1[0]),b=MX3(C0[2],C0[3],C1[1]); a=MX3(a,C1[2],C1[3]); \
      _Pragma("unroll") for(int r=4;r<16;r+=4){a=MX3(a,C0[r],C0[r+1]);b=MX3(b,C0[r+2],C0[r+3]);a=MX3(a,C1[r],C1[r+1]);b=MX3(b,C1[r+2],C1[r+3]);} \
      float rm=__builtin_fmaxf(a,b); { auto rr=__builtin_amdgcn_permlane32_swap(__float_as_uint(rm),__float_as_uint(rm),false,false); rm=__builtin_fmaxf(__uint_as_float(rr[0]),__uint_as_float(rr[1])); } \
      resc=false; \
      if(__builtin_expect(__any(rm>(float)THRL),0)){ const float dl=__builtin_fmaxf(rm,0.f); mhat+=dl; \
        _Pragma("unroll") for(int r=0;r<16;++r){C0[r]-=dl;C1[r]-=dl;} \
        _Pragma("unroll") for(int r=0;r<16;++r)negm[r]=-mhat; asm volatile("":"+v"(negm)); \
        const float f=__builtin_amdgcn_exp2f(-dl); l_reg*=f; if(hi==0)wsf[r32]=f; resc=true; } } \
    SBAR(); \
    GAPB(o[0]=__builtin_amdgcn_mfma_f32_32x32x16_bf16(PAF(0),VFR(0),o[0],0,0,0), C0,0); \
    GAPB(o[1]=__builtin_amdgcn_mfma_f32_32x32x16_bf16(PAF(0),VFR(4),o[1],0,0,0), C0,4); \
    KRD(GL,0); GAPB(o[0]=__builtin_amdgcn_mfma_f32_32x32x16_bf16(PAF(1),VFR(1),o[0],0,0,0), C0,8); \
    KRD(GL,1); GAPB(o[1]=__builtin_amdgcn_mfma_f32_32x32x16_bf16(PAF(1),VFR(5),o[1],0,0,0), C0,12); \
    KRD(GL,2); GAPB(o[0]=__builtin_amdgcn_mfma_f32_32x32x16_bf16(PAF(2),VFR(2),o[0],0,0,0), C1,0); \
    KRD(GL,3); GAPB(o[1]=__builtin_amdgcn_mfma_f32_32x32x16_bf16(PAF(2),VFR(6),o[1],0,0,0), C1,4); \
    GAPB(o[0]=__builtin_amdgcn_mfma_f32_32x32x16_bf16(PAF(3),VFR(3),o[0],0,0,0), C1,8); \
    GAPB(o[1]=__builtin_amdgcn_mfma_f32_32x32x16_bf16(PAF(3),VFR(7),o[1],0,0,0), C1,12); \
    }while(0)
  int t=1;
  for(;t+5<NT;t+=2){
    STEP(pB0,pB1,pA0,pA1,t,true,true,true);     WAIT_BAR(2); RESC(); ROT();
    STEP(pA0,pA1,pB0,pB1,t+1,true,true,true);   WAIT_BAR(2); RESC(); ROT();
  }
  #define ENDW(tt) do{ if((tt)+3<NT){WAIT_BAR(2);} else if((tt)+2<NT){WAIT_BAR(1);} else {WAIT_BAR(0);} }while(0)
  for(;t+1<NT;t+=2){
    STEP(pB0,pB1,pA0,pA1,t,(t+3<NT),(t+1<NT),(t+1<NT));       ENDW(t);   RESC(); ROT();
    STEP(pA0,pA1,pB0,pB1,t+1,(t+4<NT),(t+2<NT),(t+2<NT));     ENDW(t+1); RESC(); ROT();
  }
  STEP(pB0,pB1,pA0,pA1,NT-1,false,false,false); asm volatile("s_waitcnt lgkmcnt(0)"::"s"(tch0),"s"(tch1),"s"(tch2),"s"(tch3):"memory"); RESC();
  { float sacc=pB0[0]+pB0[1]; _Pragma("unroll") for(int r=2;r<16;++r)sacc+=pB0[r]; _Pragma("unroll") for(int r=0;r<16;++r)sacc+=pB1[r]; l_reg+=sacc;
    pw0=(u32x4){PKW(pB0,0),PKW(pB0,2),PKW(pB0,4),PKW(pB0,6)};pw1=(u32x4){PKW(pB0,8),PKW(pB0,10),PKW(pB0,12),PKW(pB0,14)};pw2=(u32x4){PKW(pB1,0),PKW(pB1,2),PKW(pB1,4),PKW(pB1,6)};pw3=(u32x4){PKW(pB1,8),PKW(pB1,10),PKW(pB1,12),PKW(pB1,14)};
    SBAR(); pv(o,vb0+sl_cur,PAF(0),PAF(1),PAF(2),PAF(3)); }
  #undef PKW
  #undef PAF
  #undef VFR
  #undef PIN
  #undef MX3
  #undef GAPA
  #undef GAPB
  #undef EX
  #undef VRD
  #undef KRD
  #undef STEP
  #undef ENDW
  {auto rr=__builtin_amdgcn_permlane32_swap(__float_as_uint(l_reg),__float_as_uint(l_reg),false,false);l_reg=__uint_as_float(rr[0])+__uint_as_float(rr[1]);}
  if(hi==0)wsf[32+r32]=l_reg;asm volatile("s_waitcnt lgkmcnt(0)":::"memory");
  float rli[16];
  #pragma unroll
  for(int r=0;r<16;++r)rli[r]=__builtin_amdgcn_rcpf(wsf[32+crow(r,hi)]);
  bf16*Ow=O+(rowbase+q0+wid*QBLK)*DM+h*D;
  { bf16*stg=(bf16*)(shm+LDS_OST)+wid*2048;
    #pragma unroll
    for(int r=0;r<16;++r){const int orow=crow(r,hi);
      #pragma unroll
      for(int d0=0;d0<2;++d0)stg[orow*64+d0*32+r32]=__float2bfloat16(o[d0][r]*rli[r]);}
    asm volatile("s_waitcnt lgkmcnt(0)":::"memory");
    #pragma unroll
    for(int i=0;i<4;++i){const int row=i*8+(lane>>3),ch=lane&7; const u32x4 v=*(const u32x4*)(stg+row*64+ch*8); ATTN_STORE16(Ow+(long)row*DM+ch*8,v);} }
  asm volatile("s_waitcnt lgkmcnt(0)\n\ts_barrier":::"memory");
  #undef DMA_K
  #undef DMA_V
  #undef CMASK
  #undef MTOUCH
  #undef MLOAD
  #undef START
  #undef RESC
  #undef ROT
}
constexpr int ATTN_LDS_BYTES=LDS_BYTES;
struct AttnTensors { const bf16* Q; const bf16* K; const bf16* V; bf16* O; MaskP mask; };
__device__ __forceinline__ void attn_phase(char*lds,const AttnTensors&T,int grid,int block){
  const int vcu=(grid%8==0)?(block%8)*(grid/8)+block/8:block;
  if(__builtin_amdgcn_readfirstlane(threadIdx.x>>6)>=4) __builtin_amdgcn_s_setprio(1);
  for(int vc=vcu;vc<256;vc+=grid){ const int s=vc&7;
    for(int i=0;i<8;++i){ const int bh=(vc>>3)+32*(i>>2), j=i&3; const int qb=(j==0)?s:(j==1)?15-s:(j==2)?16+s:31-s;
      attn_unit<8>(bh/NHEAD,bh%NHEAD,qb,T.Q,T.K,T.V,T.O,T.mask,lds); } }
  __builtin_amdgcn_s_setprio(0);
}
#undef SBAR
#undef WAIT_BAR
}
__device__ __forceinline__ void attn_phase(Frame& F) {
    LAS float* btab = (LAS float*)(F.lds + attn_body::BT_OFF);
    const float* rbp = Frel_bias;
    for (int i = F.tid; i < 8 * attn_body::BT_STRIDE; i += 512) { const int h = i / attn_body::BT_STRIDE, rel = (i % attn_body::BT_STRIDE) - 91; const int n = rel < 0 ? -rel : rel;
        int bk = n < 8 ? n : (n < 12 ? 8 : n < 16 ? 9 : n < 23 ? 10 : n < 32 ? 11 : n < 46 ? 12 : n < 64 ? 13 : n < 91 ? 14 : 15);
        if (rel > 0) bk += 16;
        btab[i] = (rbp[bk * 8 + h] - rbp[15 * 8 + h]) * LOG2E; }
    __syncthreads();
    attn_body::bf16* proj = (attn_body::bf16*)(F.ws + WS_PROJ);
    const attn_body::AttnTensors T{proj + C_QA, proj + C_KA, proj + C_VA, proj + C_QA, (attn_body::MaskP)(F.ws + WS_MASK)};
    extern __shared__ __attribute__((aligned(16))) unsigned char dyn_lds[];
    attn_body::attn_phase((char*)dyn_lds, T, F.G, (int)blockIdx.x);
}

__device__ __forceinline__ void router_phase(Frame& F) {
    LAS unsigned* lcnt = (LAS unsigned*)F.lds;
    const bf16x8* WRH = (const bf16x8*)(F.ws + WS_WRH); const bf16x8* WRL = (const bf16x8*)(F.ws + WS_WRL);
    unsigned char* H2 = (unsigned char*)(F.ws + WS_H2); unsigned* info = (unsigned*)(F.ws + WS_INFO); float* gate = (float*)(F.ws + WS_GATE); unsigned* wgcnt = (unsigned*)(F.ws + WS_WGCNT);
    const int lane = F.lane, l31 = lane & 31, hf = lane >> 5;
    for (int blk = blockIdx.x; blk < 256; blk += F.G) {
        __syncthreads();
        if (F.tid < 32) lcnt[F.tid] = 0u;
        __syncthreads();
        const int tok = blk * 256 + F.wave * 32 + l31;
        const float* xrow = F.out + (size_t)tok * DM + 8 * hf;
        unsigned char* hrow0 = H2 + (size_t)tok * DM; const float* g2p = Fg2 + 8 * hf; unsigned h2x = 0u, h2y = 0u;
        f32x16 acc = {}; float ssq = 0.f;
        f32x4 av[4], bv4[4];
#pragma unroll
        for (int t = 0; t < 4; ++t) { av[t] = *(const f32x4*)(xrow + 16 * t); bv4[t] = *(const f32x4*)(xrow + 16 * t + 4); }
        for (int k0 = 0; k0 < 64; k0 += 4) {
            f32x4 gav[4], gbv[4], na[4], nb[4]; bf16x8 whv[4], wlv[4];
#pragma unroll
            for (int t = 0; t < 4; ++t) { const int kk = k0 + t; gav[t] = *(const f32x4*)(g2p + 16 * kk); gbv[t] = *(const f32x4*)(g2p + 16 * kk + 4); whv[t] = WRH[kk * 64 + lane]; wlv[t] = WRL[kk * 64 + lane]; }
            asm volatile("" ::: "memory");
            { const int kn = (k0 + 4 < 64) ? k0 + 4 : k0;
#pragma unroll
              for (int t = 0; t < 4; ++t) { na[t] = *(const f32x4*)(xrow + 16 * (kn + t)); nb[t] = *(const f32x4*)(xrow + 16 * (kn + t) + 4); } }
            asm volatile("" ::: "memory");
#pragma unroll
            for (int t = 0; t < 4; ++t) { const int kk = k0 + t; const f32x4 a = av[t], bq = bv4[t], ga = gav[t], gb = gbv[t];
                { const unsigned wx = pk4_fp8(a.x * ga.x, a.y * ga.y, a.z * ga.z, a.w * ga.w), wy = pk4_fp8(bq.x * gb.x, bq.y * gb.y, bq.z * gb.z, bq.w * gb.w);
                  if ((t & 1) == 0) { h2x = wx; h2y = wy; }
                  else { const auto sx = __builtin_amdgcn_permlane32_swap(h2x, wx, false, false), sy = __builtin_amdgcn_permlane32_swap(h2y, wy, false, false);
                      u32x4 o; o.x = sx[0]; o.y = sy[0]; o.z = sx[1]; o.w = sy[1]; *(u32x4*)(hrow0 + 16 * (kk - 1 + hf)) = o; } }
                ssq += (a.x * a.x + a.y * a.y) + (a.z * a.z + a.w * a.w) + (bq.x * bq.x + bq.y * bq.y) + (bq.z * bq.z + bq.w * bq.w);
                u32x4 hw; hw.x = pk2(a.x, a.y); hw.y = pk2(a.z, a.w); hw.z = pk2(bq.x, bq.y); hw.w = pk2(bq.z, bq.w);
                u32x4 lw; lw.x = pk2(a.x - __uint_as_float(hw.x << 16), a.y - __uint_as_float(hw.x & 0xffff0000u)); lw.y = pk2(a.z - __uint_as_float(hw.y << 16), a.w - __uint_as_float(hw.y & 0xffff0000u));
                lw.z = pk2(bq.x - __uint_as_float(hw.z << 16), bq.y - __uint_as_float(hw.z & 0xffff0000u)); lw.w = pk2(bq.z - __uint_as_float(hw.w << 16), bq.w - __uint_as_float(hw.w & 0xffff0000u));
                const bf16x8 xh = __builtin_bit_cast(bf16x8, hw), xl = __builtin_bit_cast(bf16x8, lw);
                acc = __builtin_amdgcn_mfma_f32_32x32x16_bf16(whv[t], xh, acc, 0, 0, 0);
                acc = __builtin_amdgcn_mfma_f32_32x32x16_bf16(whv[t], xl, acc, 0, 0, 0);
                acc = __builtin_amdgcn_mfma_f32_32x32x16_bf16(wlv[t], xh, acc, 0, 0, 0); }
#pragma unroll
            for (int t = 0; t < 4; ++t) { av[t] = na[t]; bv4[t] = nb[t]; }
        }
        ssq += __shfl_xor(ssq, 32);
        const float rstd = rsqrtf(ssq * (1.f / DM) + 1e-5f);
        float lg[16];
#pragma unroll
        for (int a = 0; a < 16; ++a) lg[a] = acc[a] * rstd + Fb_router[crow(a, hf)];
        float tv[4]; int te[4];
#pragma unroll
        for (int k = 0; k < 4; ++k) { float bv = -3.0e38f; int be = 0;
#pragma unroll
            for (int a = 0; a < 16; ++a) { const bool gt = lg[a] > bv; bv = gt ? lg[a] : bv; be = gt ? crow(a, hf) : be; }
#pragma unroll
            for (int a = 0; a < 16; ++a) lg[a] = (crow(a, hf) == be) ? -3.0e38f : lg[a];
            tv[k] = bv; te[k] = be; }
        float ov[4]; int oe[4];
#pragma unroll
        for (int k = 0; k < 4; ++k) { ov[k] = __shfl_xor(tv[k], 32); oe[k] = __shfl_xor(te[k], 32); }
        float mv[4]; int me[4]; { int ia = 0, ib = 0;
#pragma unroll
            for (int k = 0; k < 4; ++k) { float va = tv[0], vb = ov[0]; int ea = te[0], eb = oe[0];
#pragma unroll
                for (int j = 1; j < 4; ++j) { va = (ia == j) ? tv[j] : va; ea = (ia == j) ? te[j] : ea; vb = (ib == j) ? ov[j] : vb; eb = (ib == j) ? oe[j] : eb; }
                const bool ta = (va > vb) || (va == vb && ea < eb); mv[k] = ta ? va : vb; me[k] = ta ? ea : eb; ia += ta ? 1 : 0; ib += ta ? 0 : 1; } }
        float ge[4]; float gs = 0.f;
#pragma unroll
        for (int k = 0; k < 4; ++k) { ge[k] = __builtin_amdgcn_exp2f((mv[k] - mv[0]) * LOG2E); gs += ge[k]; }
        const float gi = 1.0f / gs;
        if (hf == 0) {
#pragma unroll
            for (int k = 0; k < 4; ++k) { const unsigned lr = __hip_atomic_fetch_add(lcnt + me[k], 1u, __ATOMIC_RELAXED, __HIP_MEMORY_SCOPE_WORKGROUP);
                info[(size_t)tok * 4 + k] = ((unsigned)me[k] << 20) | lr; gate[(size_t)tok * 4 + k] = ge[k] * gi; } }
        if (hf == 0) ((float*)(F.ws + WS_RSTD))[tok] = rstd;
        LDS_WAIT();
        __syncthreads();
        if (F.tid < 32) wgcnt[blk * 32 + F.tid] = lcnt[F.tid];
    }
}
__device__ __forceinline__ void rows_phase(Frame& F) {
    LAS int* tot = (LAS int*)F.lds; LAS int* pre = tot + 32; LAS int* base = tot + 64;
    const unsigned* wgcnt = (const unsigned*)(F.ws + WS_WGCNT); const unsigned* info = (const unsigned*)(F.ws + WS_INFO); const float* gate = (const float*)(F.ws + WS_GATE);
    int* tokrow = (int*)(F.ws + WS_TOKROW); float* grow = (float*)(F.ws + WS_GROW); int* gbase = (int*)(F.ws + WS_BASE);
    for (int blk = blockIdx.x; blk < 256; blk += F.G) {
        __syncthreads();
        if (F.tid < 32) { int t = 0, p = 0; for (int j = 0; j < 256; ++j) { const int v = (int)wgcnt[j * 32 + F.tid]; p = (j == blk) ? t : p; t += v; } tot[F.tid] = t; pre[F.tid] = p; }
        __syncthreads();
        if (F.tid == 0) { int s = 0; for (int e = 0; e < 32; ++e) { base[e] = s; s += (tot[e] + 255) & ~255; } base[32] = s; }
        __syncthreads();
        if (blk == 0 && F.tid < 33) gbase[F.tid] = base[F.tid];
        if (blk == 0) { int* mte = (int*)(F.ws + WS_MTE); for (int mt = F.tid; mt < base[32] / 256; mt += 512) { int e = 0; for (int j = 1; j < NEXP; ++j) e = (base[j] <= mt * 256) ? j : e; mte[mt] = e; } }
        for (int i = F.tid; i < 1024; i += 512) { const int tok = blk * 256 + (i >> 2); const unsigned v = info[(size_t)blk * 1024 + i]; const int e = (int)(v >> 20), lr = (int)(v & 0xFFFFFu);
            const int row = base[e] + pre[e] + lr; tokrow[row] = tok * 4 + (i & 3); grow[row] = gate[(size_t)blk * 1024 + i]; ((float*)(F.ws + WS_RROW))[row] = ((const float*)(F.ws + WS_RSTD))[tok]; }
        if (blk < 32) { const int e = blk; for (int rr = base[e] + tot[e] + F.tid; rr < base[e + 1]; rr += 512) { tokrow[rr] = -1; grow[rr] = 0.f; ((float*)(F.ws + WS_RROW))[rr] = 0.f; } }
    }
    __syncthreads();
    LAS float* scr = (LAS float*)(F.lds + 1024 + F.wave * 16384);
    unsigned char* W1T = (unsigned char*)(F.ws + WS_W1T); unsigned char* W2T = (unsigned char*)(F.ws + WS_W2T);
    constexpr int I1 = 16 * 32, I2 = 16 * 16;
    for (int it = blockIdx.x * 8 + F.wave; it < NEXP * (I1 + I2); it += F.G * 8) {
        if (it < NEXP * I1) { const int e = it / I1, r = it % I1, kb = r / 32, nb = r % 32;
            tr_item_f8x2(Fw1 + (size_t)e * DM * 2048, 2048, DM, W1T + (size_t)e * 2048 * DM, scr, kb * 64, nb * 64, F.lane, 32.0f); }
        else { const int q = it - NEXP * I1; const int e = q / I2, r = q % I2, kb = r / 16, nb = r % 16;
            tr_item_f8x2(Fw2 + (size_t)e * DFF * DM, DM, DFF, W2T + (size_t)e * DM * DFF, scr, kb * 64, nb * 64, F.lane, 32.0f); }
    }
}
__device__ __forceinline__ void final_phase(Frame& F) {
    const int NGW = F.G * 8; const f32x4* gr = (const f32x4*)Fgf + F.lane;
    for (int m0 = blockIdx.x * 8 + F.wave; m0 < MTOK; m0 += 2 * NGW) {
        f32x4 v[2][4]; unsigned w[2][4][4]; int mr[2];
#pragma unroll
        for (int t = 0; t < 2; ++t) { const int m = m0 + t * NGW; mr[t] = m < MTOK ? m : m0;
            const f32x4* xr = (const f32x4*)(F.out + (size_t)mr[t] * DM) + F.lane; const unsigned* yr = (const unsigned*)((const unsigned char*)(F.ws + WS_Y) + (size_t)mr[t] * 4 * DM) + F.lane;
#pragma unroll
            for (int j = 0; j < 4; ++j) { v[t][j] = xr[64 * j];
#pragma unroll
                for (int k = 0; k < 4; ++k) w[t][k][j] = yr[k * 256 + 64 * j]; } }
#pragma unroll
        for (int t = 0; t < 2; ++t) { float s = 0.f;
#pragma unroll
            for (int j = 0; j < 4; ++j) {
#pragma unroll
                for (int k = 0; k < 4; ++k) { const unsigned q = w[t][k][j]; typedef float f2 __attribute__((ext_vector_type(2)));
                    const f2 lo = __builtin_amdgcn_cvt_pk_f32_fp8((int)q, false), hi = __builtin_amdgcn_cvt_pk_f32_fp8((int)q, true);
                    v[t][j].x += lo.x * 0.0625f; v[t][j].y += lo.y * 0.0625f; v[t][j].z += hi.x * 0.0625f; v[t][j].w += hi.y * 0.0625f; }
                s += (v[t][j].x * v[t][j].x + v[t][j].y * v[t][j].y) + (v[t][j].z * v[t][j].z + v[t][j].w * v[t][j].w); }
            const float r = rsqrtf(wave_sum(s) * (1.f / DM) + 1e-5f);
            if (t == 0 || m0 + NGW < MTOK) { f32x4* xo = (f32x4*)(F.out + (size_t)mr[t] * DM) + F.lane;
#pragma unroll
                for (int j = 0; j < 4; ++j) { const f32x4 g = gr[64 * j]; xo[64 * j] = v[t][j] * r * g; } } }
    }
}

constexpr int N_PHASES = 11;
__global__ void __launch_bounds__(512, 2) mk_fwd(Args args) {
    extern __shared__ __attribute__((aligned(16))) unsigned char lds[];
    Frame F;
    F.lds = (LAS unsigned char*)lds;
    F.tid = threadIdx.x; F.lane = F.tid & 63; F.wave = __builtin_amdgcn_readfirstlane(F.tid >> 6); F.G = gridDim.x;
    F.ws = args.ws; F.out = args.out;
    F.ap = (const __attribute__((address_space(4))) Args*)__builtin_amdgcn_kernarg_segment_ptr();
    volatile LAS unsigned* MISC = (volatile LAS unsigned*)(F.lds + LDSCTL_OFF);
    for (int u = F.tid; u < (LDS_BYTES - LDSCTL_OFF) / 4; u += 512) ((LAS unsigned*)(F.lds + LDSCTL_OFF))[u] = 0u;
    __syncthreads();
    unsigned* barw = (unsigned*)(F.ws + WS_CTL) + CW_BAR;
    XcdBarrier bar; bar.bar = barw; bar.x = 0; bar.st = nullptr;
    const int lo = args.ph_lo, hi = args.ph_hi;
    const bool multi = (hi - lo) > 1;
    if (multi) bar = xcd_barrier_post(barw, MISC + 8);
#ifdef ONLYP
#define IN(k) ((k) == ONLYP && lo <= (k) && (k) < hi)
#else
#define IN(k) (lo <= (k) && (k) < hi)
#endif
#define SEAM(k) do { if (IN(k) && IN((k) + 1)) xcd_barrier(bar); asm volatile("" : "+s"(F.ap)); } while (0)

    if (IN(0)) { p0_prologue(F); } SEAM(0);
    if (IN(1)) { pg8::DenseOrder<NP / 256> S; S.init(DM, F.ws + WS_WIN, F.G, (int)blockIdx.x); pg8::EpiProj E{(bf16_t*)(F.ws + WS_PROJ)};
        pg8::gemm_phase(F.lds, (const char*)(F.ws + WS_H), DM * 2, DM, S, E); } SEAM(1);
    if (IN(2)) { prep_phase(F); } SEAM(2);
    if (IN(3)) { index_phase(F); ret_scan_phase(F); } SEAM(3);
    if (IN(4)) { attn_phase(F); ret_out_phase(F); } SEAM(4);
    if (IN(5)) { pg8::DenseOrder<DM / 256> S; S.init(DM, F.ws + WS_WOUT, F.G, (int)blockIdx.x); pg8::EpiRes E{Fx, F.out};
        pg8::gemm_phase(F.lds, (const char*)(F.ws + WS_PROJ), NP * 2, DM, S, E); } SEAM(5);
    if (IN(6)) { router_phase(F); } SEAM(6);
    if (IN(7)) { rows_phase(F); } SEAM(7);
#define MOE_G1(ph, LO, CNT) if (IN(ph)) { const int* gbase = (const int*)(F.ws + WS_BASE); const int nall = gbase[32] / 256; \
        pg8::MoeOrder<8, true> S; S.G = F.G; S.c = (int)blockIdx.x; S.K = DM; S.mt_lo = (LO); S.nmt = (CNT); S.mte = (const int*)(F.ws + WS_MTE); S.tokrow = (const int*)(F.ws + WS_TOKROW); S.Wt = (const char*)(F.ws + WS_W1T); S.estride = (size_t)2048 * DM; S.esz = 1; S.rev = 0; \
        pg8::EpiSwiglu E{Fb1, (unsigned char*)(F.ws + WS_ACT), (LO), (const float*)(F.ws + WS_RROW)}; \
        pg8::gemm_phase<pg8::EpiSwiglu, pg8::MoeOrder<8, true>, 1>(F.lds, (const char*)(F.ws + WS_H2), DM, DM, S, E); } SEAM(ph);
#define MOE_G2(ph, LO, CNT) if (IN(ph)) { const int* gbase = (const int*)(F.ws + WS_BASE); const int nall = gbase[32] / 256; \
        pg8::MoeOrder<4, false> S; S.G = F.G; S.c = (int)blockIdx.x; S.K = DFF; S.mt_lo = (LO); S.nmt = (CNT); S.mte = (const int*)(F.ws + WS_MTE); S.tokrow = (const int*)(F.ws + WS_TOKROW); S.Wt = (const char*)(F.ws + WS_W2T); S.estride = (size_t)DM * DFF; S.esz = 1; S.rev = 1; \
        pg8::EpiMoeOut E{Fb2, (const int*)(F.ws + WS_TOKROW), (const float*)(F.ws + WS_GROW), (unsigned char*)(F.ws + WS_Y)}; \
        pg8::gemm_phase<pg8::EpiMoeOut, pg8::MoeOrder<4, false>, 1>(F.lds, (const char*)(F.ws + WS_ACT), DFF, DFF, S, E); } SEAM(ph);
    MOE_G1(8, 0, nall)
    MOE_G2(9, 0, nall)
    if (IN(10)) { final_phase(F); }
#undef IN
#undef SEAM
}

extern "C" void kernel_launch(void* const* d_in, const int* in_sizes, int n_in, void* d_out, int out_size, void* d_ws, size_t ws_size, hipStream_t stream) {
    static int grid = 0;
    if (grid == 0) {
        if (n_in != 16 || out_size != MTOK * DM || ws_size < WS_END) { fprintf(stderr, "kernel_launch: unexpected shapes: n_in %d out %d ws %zu (need %zu)\n", n_in, out_size, ws_size, (size_t)WS_END); grid = -1; return; }
        int dev = 0, cus = 0, per_cu = 0;
        if (hipGetDevice(&dev) != hipSuccess || hipDeviceGetAttribute(&cus, hipDeviceAttributeMultiprocessorCount, dev) != hipSuccess) { grid = -1; return; }
        if (hipFuncSetAttribute((const void*)mk_fwd, hipFuncAttributeMaxDynamicSharedMemorySize, LDS_BYTES) != hipSuccess) { fprintf(stderr, "kernel_launch: hipFuncSetAttribute failed\n"); grid = -1; return; }
        if (hipOccupancyMaxActiveBlocksPerMultiprocessor(&per_cu, (const void*)mk_fwd, 512, LDS_BYTES) != hipSuccess || per_cu < 1) fprintf(stderr, "kernel_launch: occupancy query says %d\n", per_cu);
        (void)hipGetLastError();
        grid = cus;
    }
    if (grid < 0) return;
    (void)hipMemsetAsync((char*)d_ws + WS_CTL, 0, CTL_ZERO_BYTES, stream);
    Args a{};
    for (int i = 0; i < 16; ++i) a.in[i] = (const float*)d_in[i];
    a.out = (float*)d_out; a.ws = (unsigned char*)d_ws;
#if MK_ONE_LAUNCH
    a.ph_lo = 0; a.ph_hi = N_PHASES;
    hipLaunchKernelGGL(mk_fwd, dim3(grid), dim3(512), LDS_BYTES, stream, a);
#else
    for (int p = 0; p < N_PHASES; ++p) { a.ph_lo = p; a.ph_hi = p + 1; hipLaunchKernelGGL(mk_fwd, dim3(grid), dim3(512), LDS_BYTES, stream, a); }
#endif
}
```
